# Optimizing an MI355X kernel written in HIP

```python
import jax, jax.numpy as jnp
from jax import lax

D_MODEL = 2048
BATCH = 2
SEQ = 4096
DEPTH = 1

HEAD_DIM = 128
NSA_HEADS = 16
NSA_KV_GROUPS = 2
NSA_HPG = NSA_HEADS // NSA_KV_GROUPS
CMP_BLOCK = 32
CMP_STRIDE = 16
CMP_HIDDEN = 256
SEL_BLOCK = 64
SEL_TOPK = 16
WINDOW = 512
Q_BLOCK = 128
SGU_WIDTH = 2048
SGU_GROUPS = 8
SGU_CHUNK = 128
MEM_LEN = 256
MEM_HEADS = 4
N_GROUPS = 4
EXPERTS_PER_GROUP = 16
N_EXPERTS = N_GROUPS * EXPERTS_PER_GROUP
EXPERT_TOPK = 2
EXPERT_FF = 512
MOE_BLOCK = 128
ROPE_THETA = 10000.0
LN_EPS = 1e-5
SEL_BIG = 1e9
DN_ALPHA = (2.0 * DEPTH) ** 0.25
DN_BETA = (8.0 * DEPTH) ** -0.25

Q_WIDTH = NSA_HEADS * HEAD_DIM
KV_WIDTH = 3 * 2 * NSA_KV_GROUPS * HEAD_DIM
NSA_GATE_WIDTH = 3 * NSA_HEADS
SGU_IN_WIDTH = 2 * SGU_WIDTH
MERGE_WIDTH = 2 * D_MODEL
IN_WIDTH = Q_WIDTH + KV_WIDTH + NSA_GATE_WIDTH + SGU_IN_WIDTH + MERGE_WIDTH
MEM_WIDTH = MEM_HEADS * HEAD_DIM

kernel_name = 'hybrid_nsa_sgu_hmoe_block'


def layer_norm(x, g, b):
    xf = x.astype(jnp.float32)
    mu = jnp.mean(xf, -1, keepdims=True)
    var = jnp.mean(jnp.square(xf - mu), -1, keepdims=True)
    return ((xf - mu) * lax.rsqrt(var + LN_EPS) * g + b).astype(x.dtype)


def rope_tables(pos):
    inv = ROPE_THETA ** (-jnp.arange(0, HEAD_DIM, 2, dtype=jnp.float32) / HEAD_DIM)
    ang = pos.astype(jnp.float32)[:, None] * inv[None, :]
    return jnp.cos(ang), jnp.sin(ang)


def apply_rope(t, cos, sin):
    t1, t2 = jnp.split(t, 2, axis=-1)
    c = cos[None, :, None, :]
    s = sin[None, :, None, :]
    return jnp.concatenate([t1 * c - t2 * s, t1 * s + t2 * c], -1).astype(t.dtype)


def masked_softmax(s, mask):
    s = jnp.where(mask, s.astype(jnp.float32), -jnp.inf)
    m = jnp.max(s, -1, keepdims=True)
    m = jnp.where(jnp.isfinite(m), m, 0.0)
    p = jnp.exp(s - m)
    return p / jnp.maximum(jnp.sum(p, -1, keepdims=True), 1e-30)


def compress_blocks(t, pe, w1, w2):
    B, S, G, D = t.shape
    c = t.reshape(B, S // CMP_STRIDE, CMP_STRIDE, G, D)
    blocks = jnp.concatenate([c[:, :-1], c[:, 1:]], axis=2)
    blocks = blocks + pe[None, None, :, None, :]
    n_cmp = blocks.shape[1]
    flat = jnp.moveaxis(blocks, 3, 2).reshape(B, n_cmp, G, CMP_BLOCK * D)
    return jax.nn.gelu(flat @ w1) @ w2


def nsa_attention(q, k_cmp, v_cmp, cmp_end, k_slc, v_slc, k_win, v_win, gates):
    B, S, H, D = q.shape
    G, HPG = NSA_KV_GROUPS, NSA_HPG
    n_cmp = k_cmp.shape[1]
    n_sel = S // SEL_BLOCK
    n_pick = min(SEL_TOPK, n_sel)
    nq = S // Q_BLOCK
    ci = CMP_STRIDE * jnp.arange(n_cmp)
    sj = SEL_BLOCK * jnp.arange(n_sel)
    overlap = jnp.clip(jnp.minimum(ci[:, None] + CMP_BLOCK, sj[None, :] + SEL_BLOCK)
                       - jnp.maximum(ci[:, None], sj[None, :]), 0, None)
    sel_map = overlap.astype(jnp.float32) / CMP_BLOCK

    def to_blocks(t):
        return t.reshape(B, n_sel, SEL_BLOCK, G, D).transpose(0, 3, 1, 2, 4).reshape(B, G, n_sel, SEL_BLOCK * D)

    ks_b, vs_b = to_blocks(k_slc), to_blocks(v_slc)
    pad = ((0, 0), (WINDOW, 0), (0, 0), (0, 0))
    kw_p, vw_p = jnp.pad(k_win, pad), jnp.pad(v_win, pad)
    q_blk = q.reshape(B, nq, Q_BLOCK, G, HPG, D).swapaxes(0, 1)
    g_blk = gates.reshape(B, nq, Q_BLOCK, G, HPG, 3).swapaxes(0, 1)
    sel_ids = jnp.arange(n_sel)
    win_off = jnp.arange(WINDOW + Q_BLOCK)
    b_ix = jnp.arange(B)[:, None, None]
    g_ix = jnp.arange(G)[None, :, None]

    def one_block(args):
        c, qc, gc = args
        t = c * Q_BLOCK + jnp.arange(Q_BLOCK)
        s_c = jnp.einsum('btgnd,bkgd->btgnk', qc, k_cmp)
        m_c = cmp_end[None, :] <= t[:, None]
        p_c = masked_softmax(s_c, m_c[None, :, None, None, :])
        o_c = jnp.einsum('btgnk,bkgd->btgnd', p_c.astype(v_cmp.dtype), v_cmp)
        imp = jnp.einsum('btgnk,kj->btgj', p_c, sel_map)
        cur = t // SEL_BLOCK
        visible = sel_ids[None, :] <= cur[:, None]
        forced = (sel_ids[None, :] == 0) | (sel_ids[None, :] == cur[:, None]) | (sel_ids[None, :] == cur[:, None] - 1)
        score = jnp.where(forced[None, :, None, :], SEL_BIG,
                          jnp.where(visible[None, :, None, :], imp, -SEL_BIG))
        _, idx = lax.top_k(score, n_pick)
        idx_bg = jnp.moveaxis(idx, 2, 1).reshape(B, G, Q_BLOCK * n_pick)
        k_sel = ks_b[b_ix, g_ix, idx_bg].reshape(B, G, Q_BLOCK, n_pick * SEL_BLOCK, D)
        v_sel = vs_b[b_ix, g_ix, idx_bg].reshape(B, G, Q_BLOCK, n_pick * SEL_BLOCK, D)
        s_s = jnp.einsum('btgnd,bgtkd->btgnk', qc, k_sel)
        key_pos = (idx[..., None] * SEL_BLOCK + jnp.arange(SEL_BLOCK)).reshape(B, Q_BLOCK, G, n_pick * SEL_BLOCK)
        m_s = key_pos <= t[None, :, None, None]
        p_s = masked_softmax(s_s, m_s[:, :, :, None, :])
        o_s = jnp.einsum('btgnk,bgtkd->btgnd', p_s.astype(v_sel.dtype), v_sel)
        kwc = lax.dynamic_slice_in_dim(kw_p, c * Q_BLOCK, WINDOW + Q_BLOCK, axis=1)
        vwc = lax.dynamic_slice_in_dim(vw_p, c * Q_BLOCK, WINDOW + Q_BLOCK, axis=1)
        s_w = jnp.einsum('btgnd,bkgd->btgnk', qc, kwc)
        kp = c * Q_BLOCK - WINDOW + win_off
        m_w = (kp[None, :] >= 0) & (kp[None, :] <= t[:, None]) & (t[:, None] - kp[None, :] < WINDOW)
        p_w = masked_softmax(s_w, m_w[None, :, None, None, :])
        o_w = jnp.einsum('btgnk,bkgd->btgnd', p_w.astype(vwc.dtype), vwc)
        return gc[..., 0:1] * o_c + gc[..., 1:2] * o_s + gc[..., 2:3] * o_w

    out = lax.map(one_block, (jnp.arange(nq, dtype=jnp.int32), q_blk, g_blk))
    return out.swapaxes(0, 1).reshape(B, S, H * D)


def spatial_gating(u, v, ln_g, ln_b, w_s, b_s):
    B, S, _ = v.shape
    u = jax.nn.gelu(u)
    v = layer_norm(jax.nn.gelu(v), ln_g, ln_b)
    vc = v.reshape(B, S // SGU_CHUNK, SGU_CHUNK, SGU_GROUPS, SGU_WIDTH // SGU_GROUPS)
    causal = jnp.tril(jnp.ones((SGU_CHUNK, SGU_CHUNK), dtype=bool))
    w_causal = jnp.where(causal[None], w_s, jnp.zeros_like(w_s))
    z = jnp.einsum('gts,bcsgd->bctgd', w_causal, vc) + b_s.T[None, None, :, :, None]
    return u * z.reshape(B, S, SGU_WIDTH)


def memory_cross_attention(x, mem, w_xq, w_xk, w_xv, w_xo):
    B, S, _ = x.shape
    M = mem.shape[1]
    q = (x @ w_xq).reshape(B, S, MEM_HEADS, HEAD_DIM) * HEAD_DIM ** -0.5
    k = (mem @ w_xk).reshape(B, M, MEM_HEADS, HEAD_DIM)
    v = (mem @ w_xv).reshape(B, M, MEM_HEADS, HEAD_DIM)
    p = jax.nn.softmax(jnp.einsum('bshd,bmhd->bhsm', q, k).astype(jnp.float32), axis=-1)
    o = jnp.einsum('bhsm,bmhd->bshd', p.astype(v.dtype), v).reshape(B, S, MEM_WIDTH)
    return o @ w_xo


def hierarchical_moe(x, w_router_grp, b_router_grp, w_router_exp, b_router_exp, w_exp_gate, w_exp_up, w_exp_down):
    B, S, D = x.shape
    N = B * S
    xf = x.reshape(N, D)
    p_grp = jax.nn.softmax((xf @ w_router_grp).astype(jnp.float32) + b_router_grp, axis=-1)
    g_grp, grp = lax.top_k(p_grp, 1)
    logit_exp = ((xf @ w_router_exp).astype(jnp.float32) + b_router_exp).reshape(N, N_GROUPS, EXPERTS_PER_GROUP)
    logit_in = logit_exp[jnp.arange(N), grp[:, 0]]
    g_in, local = lax.top_k(jax.nn.softmax(logit_in, axis=-1), EXPERT_TOPK)
    gate = g_grp * g_in / jnp.sum(g_in, -1, keepdims=True)
    expert = grp * EXPERTS_PER_GROUP + local
    NK = N * EXPERT_TOPK
    e_flat = expert.reshape(NK)
    tok_flat = jnp.repeat(jnp.arange(N, dtype=jnp.int32), EXPERT_TOPK)
    w_flat = gate.reshape(NK)
    order = jnp.argsort(e_flat)
    e_s = e_flat[order]
    counts = jnp.bincount(e_flat, length=N_EXPERTS)
    start = jnp.cumsum(counts) - counts
    pcounts = ((counts + MOE_BLOCK - 1) // MOE_BLOCK) * MOE_BLOCK
    pend = jnp.cumsum(pcounts)
    pstart = pend - pcounts
    dest = pstart[e_s] + (jnp.arange(NK) - start[e_s])
    n_blocks = -(-NK // MOE_BLOCK) + N_EXPERTS
    P = n_blocks * MOE_BLOCK
    row_tok = jnp.full((P,), N, dtype=jnp.int32).at[dest].set(tok_flat[order])
    row_w = jnp.zeros((P,), jnp.float32).at[dest].set(w_flat[order])
    blk_exp = jnp.minimum(jnp.searchsorted(pend, jnp.arange(n_blocks) * MOE_BLOCK, side='right'), N_EXPERTS - 1)
    x_pad = jnp.concatenate([xf, jnp.zeros((1, D), xf.dtype)], axis=0)

    def block_ffn(args):
        tok, wr, e = args
        h = x_pad[tok]
        a = jax.nn.silu(h @ w_exp_gate[e]) * (h @ w_exp_up[e])
        return (a @ w_exp_down[e]) * wr[:, None].astype(h.dtype)

    y_rows = lax.map(block_ffn, (row_tok.reshape(n_blocks, MOE_BLOCK), row_w.reshape(n_blocks, MOE_BLOCK), blk_exp))
    out = jnp.zeros((N + 1, D), x.dtype).at[row_tok].add(y_rows.reshape(P, D))[:N]
    return out.reshape(B, S, D)


def hybrid_layer(x, mem, w_in, cmp_pe_k, cmp_w1_k, cmp_w2_k, cmp_pe_v, cmp_w1_v, cmp_w2_v,
                 sgu_ln_g, sgu_ln_b, sgu_w_s, sgu_b_s, w_branch_a, w_branch_b, w_o, ln1_g, ln1_b,
                 w_xq, w_xk, w_xv, w_xo, ln2_g, ln2_b,
                 w_router_grp, b_router_grp, w_router_exp, b_router_exp,
                 w_exp_gate, w_exp_up, w_exp_down, ln3_g, ln3_b):
    B, S, _ = x.shape
    cuts = [Q_WIDTH, Q_WIDTH + KV_WIDTH, Q_WIDTH + KV_WIDTH + NSA_GATE_WIDTH,
            Q_WIDTH + KV_WIDTH + NSA_GATE_WIDTH + SGU_WIDTH,
            Q_WIDTH + KV_WIDTH + NSA_GATE_WIDTH + SGU_IN_WIDTH]
    q, kv, g_nsa, u, v, g_merge = jnp.split(x @ w_in, cuts, axis=-1)
    cos, sin = rope_tables(jnp.arange(S, dtype=jnp.int32))
    q = apply_rope(q.reshape(B, S, NSA_HEADS, HEAD_DIM), cos, sin) * HEAD_DIM ** -0.5
    kv = kv.reshape(B, S, 3, 2, NSA_KV_GROUPS, HEAD_DIM)
    k_cmp = compress_blocks(kv[:, :, 0, 0], cmp_pe_k, cmp_w1_k, cmp_w2_k)
    v_cmp = compress_blocks(kv[:, :, 0, 1], cmp_pe_v, cmp_w1_v, cmp_w2_v)
    cmp_end = CMP_STRIDE * jnp.arange(k_cmp.shape[1], dtype=jnp.int32) + CMP_BLOCK - 1
    ccos, csin = rope_tables(cmp_end)
    k_cmp = apply_rope(k_cmp, ccos, csin)
    k_slc = apply_rope(kv[:, :, 1, 0], cos, sin)
    k_win = apply_rope(kv[:, :, 2, 0], cos, sin)
    o_nsa = nsa_attention(q, k_cmp, v_cmp, cmp_end, k_slc, kv[:, :, 1, 1], k_win, kv[:, :, 2, 1],
                          jax.nn.sigmoid(g_nsa.reshape(B, S, NSA_HEADS, 3)))
    o_sgu = spatial_gating(u, v, sgu_ln_g, sgu_ln_b, sgu_w_s, sgu_b_s)
    g_a, g_b = jnp.split(jax.nn.sigmoid(g_merge), 2, axis=-1)
    merged = g_a * (o_nsa @ w_branch_a) + g_b * (o_sgu @ w_branch_b)
    x = layer_norm(DN_ALPHA * x + merged @ w_o, ln1_g, ln1_b)
    x = layer_norm(DN_ALPHA * x + memory_cross_attention(x, mem, w_xq, w_xk, w_xv, w_xo), ln2_g, ln2_b)
    moe = hierarchical_moe(x, w_router_grp, b_router_grp, w_router_exp, b_router_exp, w_exp_gate, w_exp_up, w_exp_down)
    return layer_norm(DN_ALPHA * x + moe, ln3_g, ln3_b)


def setup_inputs(seed: int = 0) -> dict:
    key = jax.random.key(seed)
    ks = jax.random.split(key, 40)
    L, D = DEPTH, D_MODEL

    def nrm(k, shape, scale):
        return jax.random.normal(k, shape, jnp.float32) * scale

    return {
        'x': nrm(ks[0], (BATCH, SEQ, D), 1.0),
        'mem': nrm(ks[1], (BATCH, MEM_LEN, D), 1.0),
        'w_in': nrm(ks[2], (L, D, IN_WIDTH), D ** -0.5),
        'cmp_pe_k': nrm(ks[3], (L, CMP_BLOCK, HEAD_DIM), 0.1),
        'cmp_w1_k': nrm(ks[4], (L, CMP_BLOCK * HEAD_DIM, CMP_HIDDEN), (CMP_BLOCK * HEAD_DIM) ** -0.5),
        'cmp_w2_k': nrm(ks[5], (L, CMP_HIDDEN, HEAD_DIM), CMP_HIDDEN ** -0.5),
        'cmp_pe_v': nrm(ks[6], (L, CMP_BLOCK, HEAD_DIM), 0.1),
        'cmp_w1_v': nrm(ks[7], (L, CMP_BLOCK * HEAD_DIM, CMP_HIDDEN), (CMP_BLOCK * HEAD_DIM) ** -0.5),
        'cmp_w2_v': nrm(ks[8], (L, CMP_HIDDEN, HEAD_DIM), CMP_HIDDEN ** -0.5),
        'sgu_ln_g': 1.0 + nrm(ks[9], (L, SGU_WIDTH), 0.02),
        'sgu_ln_b': nrm(ks[10], (L, SGU_WIDTH), 0.02),
        'sgu_w_s': nrm(ks[11], (L, SGU_GROUPS, SGU_CHUNK, SGU_CHUNK), SGU_CHUNK ** -0.5),
        'sgu_b_s': 1.0 + nrm(ks[12], (L, SGU_GROUPS, SGU_CHUNK), 0.1),
        'w_branch_a': nrm(ks[13], (L, Q_WIDTH, D), Q_WIDTH ** -0.5),
        'w_branch_b': nrm(ks[14], (L, SGU_WIDTH, D), SGU_WIDTH ** -0.5),
        'w_o': nrm(ks[15], (L, D, D), DN_BETA * D ** -0.5),
        'ln1_g': 1.0 + nrm(ks[16], (L, D), 0.02),
        'ln1_b': nrm(ks[17], (L, D), 0.02),
        'w_xq': nrm(ks[18], (L, D, MEM_WIDTH), D ** -0.5),
        'w_xk': nrm(ks[19], (L, D, MEM_WIDTH), D ** -0.5),
        'w_xv': nrm(ks[20], (L, D, MEM_WIDTH), D ** -0.5),
        'w_xo': nrm(ks[21], (L, MEM_WIDTH, D), DN_BETA * MEM_WIDTH ** -0.5),
        'ln2_g': 1.0 + nrm(ks[22], (L, D), 0.02),
        'ln2_b': nrm(ks[23], (L, D), 0.02),
        'w_router_grp': nrm(ks[24], (L, D, N_GROUPS), D ** -0.5),
        'b_router_grp': nrm(ks[25], (L, N_GROUPS), 0.01),
        'w_router_exp': nrm(ks[26], (L, D, N_EXPERTS), D ** -0.5),
        'b_router_exp': nrm(ks[27], (L, N_EXPERTS), 0.01),
        'w_exp_gate': nrm(ks[28], (L, N_EXPERTS, D, EXPERT_FF), D ** -0.5),
        'w_exp_up': nrm(ks[29], (L, N_EXPERTS, D, EXPERT_FF), D ** -0.5),
        'w_exp_down': nrm(ks[30], (L, N_EXPERTS, EXPERT_FF, D), DN_BETA * EXPERT_FF ** -0.5),
        'ln3_g': 1.0 + nrm(ks[31], (L, D), 0.02),
        'ln3_b': nrm(ks[32], (L, D), 0.02),
    }


def reference(x, mem, w_in, cmp_pe_k, cmp_w1_k, cmp_w2_k, cmp_pe_v, cmp_w1_v, cmp_w2_v,
              sgu_ln_g, sgu_ln_b, sgu_w_s, sgu_b_s, w_branch_a, w_branch_b, w_o, ln1_g, ln1_b,
              w_xq, w_xk, w_xv, w_xo, ln2_g, ln2_b,
              w_router_grp, b_router_grp, w_router_exp, b_router_exp,
              w_exp_gate, w_exp_up, w_exp_down, ln3_g, ln3_b):
    layer_params = (w_in, cmp_pe_k, cmp_w1_k, cmp_w2_k, cmp_pe_v, cmp_w1_v, cmp_w2_v,
                    sgu_ln_g, sgu_ln_b, sgu_w_s, sgu_b_s, w_branch_a, w_branch_b, w_o, ln1_g, ln1_b,
                    w_xq, w_xk, w_xv, w_xo, ln2_g, ln2_b,
                    w_router_grp, b_router_grp, w_router_exp, b_router_exp,
                    w_exp_gate, w_exp_up, w_exp_down, ln3_g, ln3_b)
    h = x
    for l in range(DEPTH):
        h = hybrid_layer(h, mem, *[p[l] for p in layer_params])
    return h
```

```cpp
#include <hip/hip_runtime.h>
#include <hip/hip_cooperative_groups.h>
#include <stdint.h>
#include <cstdio>
namespace cg = cooperative_groups;

#ifndef MK_MULTI
#define MK_MULTI 0
#endif

constexpr int D_MODEL = 2048, BATCH = 2, SEQ = 4096, NTOK = BATCH * SEQ;
constexpr int HD = 128, NH = 16, NG = 2, HPG = 8;
constexpr int NCMP = 255;
constexpr int INW = 11824;
constexpr int OFF_Q = 0, OFF_KV = 2048, OFF_G = 3584, OFF_U = 3632, OFF_V = 5680, OFF_GM = 7728;
constexpr int MEM_LEN = 256, MEMW = 512;
constexpr int NEXP = 64, EFF = 512;
constexpr int LISTCAP = 8192;
constexpr float DN_ALPHA = 1.189207115002721f;
constexpr float LN_EPS = 1e-5f;
constexpr float QSCALE = 0.08838834764831845f;
constexpr int NTHR = 256;

struct Params {
    const float* x; const float* mem; const float* w_in;
    const float* cmp_pe_k; const float* cmp_w1_k; const float* cmp_w2_k;
    const float* cmp_pe_v; const float* cmp_w1_v; const float* cmp_w2_v;
    const float* sgu_ln_g; const float* sgu_ln_b; const float* sgu_w_s; const float* sgu_b_s;
    const float* w_branch_a; const float* w_branch_b; const float* w_o; const float* ln1_g; const float* ln1_b;
    const float* w_xq; const float* w_xk; const float* w_xv; const float* w_xo; const float* ln2_g; const float* ln2_b;
    const float* w_router_grp; const float* b_router_grp; const float* w_router_exp; const float* b_router_exp;
    const float* w_exp_gate; const float* w_exp_up; const float* w_exp_down; const float* ln3_g; const float* ln3_b;
    float* out;
    float* XW;
    float* KC;
    float* VC;
    float* OC;
    unsigned long long* SELMASK;
    float* ONSA;
    float* VN;
    float* OSGU;
    float* MERGED;
    float* X1;
    float* X2;
    float* QX;
    float* KX;
    float* VX;
    float* OX;
    int* CNT;
    int* LIST;
    float* WGT;
    float* HB;
    float* Y;
    int phase_lo; int phase_hi;
};

__device__ __forceinline__ float gelu_tanh(float x) {
    const float k0 = 0.7978845608028654f, k1 = 0.044715f;
    float inner = k0 * (x + k1 * x * x * x);
    return 0.5f * x * (1.0f + tanhf(inner));
}
__device__ __forceinline__ float sigmoidf_(float x) { return 1.0f / (1.0f + expf(-x)); }

__device__ __forceinline__ float wave_sum(float v) {
#pragma unroll
    for (int o = 32; o > 0; o >>= 1) v += __shfl_xor(v, o);
    return v;
}
__device__ __forceinline__ float wave_max(float v) {
#pragma unroll
    for (int o = 32; o > 0; o >>= 1) v = fmaxf(v, __shfl_xor(v, o));
    return v;
}
__device__ __forceinline__ float block_sum(float v, float* red) {
    v = wave_sum(v);
    __syncthreads();
    if ((threadIdx.x & 63) == 0) red[threadIdx.x >> 6] = v;
    __syncthreads();
    float r = red[0] + red[1] + red[2] + red[3];
    return r;
}

template <bool DUAL, class Epi>
__device__ __forceinline__ void sgemm_tile(const float* __restrict__ A, int lda, const int* __restrict__ arow, int ashift,
                                           int m0, int mcount,
                                           const float* __restrict__ B, const float* __restrict__ B2, int ldb, int n0, int N, int K,
                                           float* smem, Epi epi) {
    float* As = smem;
    float* Bs = smem + 16 * 68;
    float* Bs2 = Bs + 16 * 64;
    const int tid = threadIdx.x;
    const int tx = tid & 15, ty = tid >> 4;
    const int ar = tid >> 2, ak = (tid & 3) * 4;
    const int bk = tid >> 4, bn = (tid & 15) * 4;
    const float* aptr = nullptr;
    if (ar < mcount) {
        int src = arow ? (arow[m0 + ar] >> ashift) : (m0 + ar);
        aptr = A + (size_t)src * lda + ak;
    }
    const bool bvalid = (n0 + bn) < N;
    const float* bptr = B + (size_t)bk * ldb + n0 + bn;
    const float* bptr2 = DUAL ? (B2 + (size_t)bk * ldb + n0 + bn) : nullptr;
    float acc[4][4], acc2[4][4];
#pragma unroll
    for (int i = 0; i < 4; ++i)
#pragma unroll
        for (int j = 0; j < 4; ++j) { acc[i][j] = 0.f; acc2[i][j] = 0.f; }
    for (int k0 = 0; k0 < K; k0 += 16) {
        float4 av = make_float4(0.f, 0.f, 0.f, 0.f), bv = av, bv2 = av;
        if (aptr) av = *(const float4*)(aptr + k0);
        if (bvalid) {
            bv = *(const float4*)(bptr + (size_t)k0 * ldb);
            if (DUAL) bv2 = *(const float4*)(bptr2 + (size_t)k0 * ldb);
        }
        __syncthreads();
        As[(ak + 0) * 68 + ar] = av.x; As[(ak + 1) * 68 + ar] = av.y; As[(ak + 2) * 68 + ar] = av.z; As[(ak + 3) * 68 + ar] = av.w;
        *(float4*)&Bs[bk * 64 + bn] = bv;
        if (DUAL) *(float4*)&Bs2[bk * 64 + bn] = bv2;
        __syncthreads();
#pragma unroll
        for (int kk = 0; kk < 16; ++kk) {
            float4 a = *(const float4*)&As[kk * 68 + ty * 4];
            float4 b = *(const float4*)&Bs[kk * 64 + tx * 4];
            float a4[4] = {a.x, a.y, a.z, a.w};
            float b4[4] = {b.x, b.y, b.z, b.w};
#pragma unroll
            for (int i = 0; i < 4; ++i)
#pragma unroll
                for (int j = 0; j < 4; ++j) acc[i][j] = fmaf(a4[i], b4[j], acc[i][j]);
            if (DUAL) {
                float4 c = *(const float4*)&Bs2[kk * 64 + tx * 4];
                float c4[4] = {c.x, c.y, c.z, c.w};
#pragma unroll
                for (int i = 0; i < 4; ++i)
#pragma unroll
                    for (int j = 0; j < 4; ++j) acc2[i][j] = fmaf(a4[i], c4[j], acc2[i][j]);
            }
        }
    }
#pragma unroll
    for (int i = 0; i < 4; ++i) {
        int r = ty * 4 + i;
        if (r < mcount) {
#pragma unroll
            for (int j = 0; j < 4; ++j) {
                int c = n0 + tx * 4 + j;
                if (c < N) epi(m0 + r, c, acc[i][j], acc2[i][j]);
            }
        }
    }
    __syncthreads();
}

template <class Epi>
__device__ void dense_gemm_phase(const float* A, int lda, const float* B, int ldb, int M, int N, int K, float* smem, Epi epi) {
    const int mt = (M + 63) / 64, nt = (N + 63) / 64;
    for (int u = blockIdx.x; u < mt * nt; u += gridDim.x) {
        int tm = u % mt, tn = u / mt;
        int m0 = tm * 64; int mc = min(64, M - m0);
        sgemm_tile<false>(A, lda, nullptr, 0, m0, mc, B, nullptr, ldb, tn * 64, N, K, smem, epi);
    }
}

__device__ void ph_gemm_xw(const Params& p, float* smem) {
    if (blockIdx.x == 0 && threadIdx.x < NEXP) p.CNT[threadIdx.x] = 0;
    float* XW = p.XW;
    dense_gemm_phase(p.x, D_MODEL, p.w_in, INW, NTOK, INW, D_MODEL, smem,
                     [=](int r, int c, float v, float) { XW[(size_t)r * INW + c] = v; });
}

__device__ __forceinline__ void rope_angles(int pos, int d, float& c, float& s) {
    float inv = powf(10000.0f, -(float)(2 * d) / 128.0f);
    float ang = (float)pos * inv;
    c = cosf(ang); s = sinf(ang);
}

__device__ void ph_act(const Params& p) {
    const size_t total = (size_t)NTOK * INW;
    for (size_t idx = (size_t)blockIdx.x * NTHR + threadIdx.x; idx < total; idx += (size_t)gridDim.x * NTHR) {
        int tok = (int)(idx / INW), col = (int)(idx % INW);
        int pos = tok % SEQ;
        float* row = p.XW + (size_t)tok * INW;
        if (col < OFF_KV) {
            int d = col & 127;
            if (d < 64) {
                float c, s; rope_angles(pos, d, c, s);
                float t1 = row[col], t2 = row[col + 64];
                row[col] = (t1 * c - t2 * s) * QSCALE;
                row[col + 64] = (t1 * s + t2 * c) * QSCALE;
            }
        } else if (col < OFF_G) {
            int ch = (col - OFF_KV) >> 7; int d = col & 127;
            bool rp = (ch == 4 || ch == 5 || ch == 8 || ch == 9);
            if (rp && d < 64) {
                float c, s; rope_angles(pos, d, c, s);
                float t1 = row[col], t2 = row[col + 64];
                row[col] = t1 * c - t2 * s;
                row[col + 64] = t1 * s + t2 * c;
            }
        } else if (col < OFF_U) {
            row[col] = sigmoidf_(row[col]);
        } else if (col < OFF_GM) {
            row[col] = gelu_tanh(row[col]);
        } else {
            row[col] = sigmoidf_(row[col]);
        }
    }
}

__device__ void ph_compress(const Params& p, float* smem) {
    float* a = smem;
    float* hid = smem + 4096;
    float* o = hid + 256;
    const int tid = threadIdx.x;
    for (int u = blockIdx.x; u < BATCH * NCMP * 4; u += gridDim.x) {
        int kvsel = u & 1, g = (u >> 1) & 1, bi = u >> 2;
        int b = bi / NCMP, i = bi % NCMP;
        const float* pe = kvsel ? p.cmp_pe_v : p.cmp_pe_k;
        const float* w1 = kvsel ? p.cmp_w1_v : p.cmp_w1_k;
        const float* w2 = kvsel ? p.cmp_w2_v : p.cmp_w2_k;
        __syncthreads();
        for (int e = tid; e < 4096; e += NTHR) {
            int pp = e >> 7, d = e & 127;
            a[e] = p.XW[(size_t)(b * SEQ + 16 * i + pp) * INW + OFF_KV + (kvsel * 2 + g) * 128 + d] + pe[e];
        }
        __syncthreads();
        float acc = 0.f;
        for (int k = 0; k < 4096; ++k) acc = fmaf(a[k], w1[(size_t)k * 256 + tid], acc);
        hid[tid] = gelu_tanh(acc);
        __syncthreads();
        if (tid < 128) {
            float s = 0.f;
            for (int n = 0; n < 256; ++n) s = fmaf(hid[n], w2[n * 128 + tid], s);
            o[tid] = s;
        }
        __syncthreads();
        float* dst = (kvsel ? p.VC : p.KC) + (size_t)((b * NCMP + i) * 2 + g) * 128;
        if (kvsel) {
            if (tid < 128) dst[tid] = o[tid];
        } else if (tid < 64) {
            float c, s; rope_angles(16 * i + 31, tid, c, s);
            float t1 = o[tid], t2 = o[tid + 64];
            dst[tid] = t1 * c - t2 * s;
            dst[tid + 64] = t1 * s + t2 * c;
        }
    }
}

__device__ void ph_cmp_attn(const Params& p, float* smem) {
    float* qs = smem;
    float* S = smem + 1024;
    float* Psum = S + 2048;
    float* sc = Psum + 256;
    const int tid = threadIdx.x, lane = tid & 63, wave = tid >> 6;
    for (int u = blockIdx.x; u < NTOK * 2; u += gridDim.x) {
        int tok = u >> 1, g = u & 1;
        int b = tok / SEQ, t = tok % SEQ;
        int nvalid = (t >= 31) ? ((t - 31) / 16 + 1) : 0;
        if (nvalid > NCMP) nvalid = NCMP;
        __syncthreads();
        for (int e = tid; e < 1024; e += NTHR) qs[e] = p.XW[(size_t)tok * INW + g * 1024 + e];
        __syncthreads();
        {
            int k = tid;
            float s8[8];
#pragma unroll
            for (int n = 0; n < 8; ++n) s8[n] = 0.f;
            if (k < nvalid) {
                const float* kr = p.KC + (size_t)((b * NCMP + k) * 2 + g) * 128;
                for (int d = 0; d < 128; d += 4) {
                    float4 kv = *(const float4*)(kr + d);
#pragma unroll
                    for (int n = 0; n < 8; ++n) {
                        float4 q = *(const float4*)&qs[n * 128 + d];
                        s8[n] += q.x * kv.x + q.y * kv.y + q.z * kv.z + q.w * kv.w;
                    }
                }
            }
#pragma unroll
            for (int n = 0; n < 8; ++n) S[n * 256 + k] = (k < nvalid) ? s8[n] : -INFINITY;
        }
        __syncthreads();
#pragma unroll
        for (int hh = 0; hh < 2; ++hh) {
            int n = wave * 2 + hh;
            float v[4]; float m = -INFINITY;
#pragma unroll
            for (int i = 0; i < 4; ++i) { v[i] = S[n * 256 + lane + 64 * i]; m = fmaxf(m, v[i]); }
            m = wave_max(m);
            float sum = 0.f;
            if (nvalid > 0) {
#pragma unroll
                for (int i = 0; i < 4; ++i) { v[i] = expf(v[i] - m); sum += v[i]; }
            } else {
#pragma unroll
                for (int i = 0; i < 4; ++i) v[i] = 0.f;
            }
            sum = wave_sum(sum);
            float inv = 1.0f / fmaxf(sum, 1e-30f);
#pragma unroll
            for (int i = 0; i < 4; ++i) S[n * 256 + lane + 64 * i] = v[i] * inv;
        }
        __syncthreads();
        {
            int d = tid & 127, n0 = tid >> 7;
            float o4[4] = {0.f, 0.f, 0.f, 0.f};
            for (int k = 0; k < nvalid; ++k) {
                float vv = p.VC[(size_t)((b * NCMP + k) * 2 + g) * 128 + d];
#pragma unroll
                for (int r = 0; r < 4; ++r) o4[r] = fmaf(S[(n0 + 2 * r) * 256 + k], vv, o4[r]);
            }
#pragma unroll
            for (int r = 0; r < 4; ++r) p.OC[((size_t)tok * 16 + g * 8 + n0 + 2 * r) * 128 + d] = o4[r];
        }
        {
            float ps = 0.f;
#pragma unroll
            for (int n = 0; n < 8; ++n) ps += S[n * 256 + tid];
            Psum[tid] = ps;
        }
        __syncthreads();
        const int cur = t / 64;
        if (tid < 64) {
            int j = tid;
            float imp = 0.f;
            int k0 = 4 * j;
            if (k0 - 1 >= 0) imp += 0.5f * Psum[k0 - 1];
            imp += Psum[k0];
            imp += Psum[k0 + 1];
            imp += Psum[k0 + 2];
            if (k0 + 3 < NCMP) imp += 0.5f * Psum[k0 + 3];
            bool forced = (j == 0) || (j == cur) || (j == cur - 1);
            bool visible = j <= cur;
            sc[j] = forced ? 1e9f : (visible ? imp : -1e9f);
        }
        __syncthreads();
        if (tid < 64) {
            int j = tid; float me = sc[j]; int rank = 0;
            for (int jj = 0; jj < 64; ++jj) {
                float o = sc[jj];
                rank += (o > me || (o == me && jj < j)) ? 1 : 0;
            }
            unsigned long long m = __ballot(rank < 16);
            if (tid == 0) p.SELMASK[u] = m;
        }
    }
}

__device__ void ph_nsa_main(const Params& p, float* smem) {
    const int tid = threadIdx.x, lane = tid & 63, wave = tid >> 6;
    float* qs = smem + wave * 1664;
    float* sc = qs + 128;
    for (int u = blockIdx.x; u < NTOK * 4; u += gridDim.x) {
        int tok = u >> 2, hq = u & 3;
        int h = hq * 4 + wave, g = h >> 3;
        int b = tok / SEQ, t = tok % SEQ;
        const int cur = t / 64;
        unsigned long long mask = p.SELMASK[tok * 2 + g];
        const float* xrow = p.XW + (size_t)tok * INW;
        __syncthreads();
        qs[lane] = xrow[h * 128 + lane];
        qs[lane + 64] = xrow[h * 128 + 64 + lane];
        __syncthreads();
        const size_t bbase = (size_t)b * SEQ;
        const int colKS = OFF_KV + (4 + g) * 128, colVS = OFF_KV + (6 + g) * 128, colKW = OFF_KV + (8 + g) * 128, colVW = OFF_KV + (10 + g) * 128;
        int nsel = 0;
        for (int j = 0; j <= cur; ++j) {
            if (!((mask >> j) & 1ull)) continue;
            int key = 64 * j + lane;
            float s = -INFINITY;
            if (key <= t) {
                const float* kr = p.XW + (bbase + key) * INW + colKS;
                float acc = 0.f;
                for (int d = 0; d < 128; d += 4) {
                    float4 kv = *(const float4*)(kr + d);
                    float4 q = *(const float4*)&qs[d];
                    acc += q.x * kv.x + q.y * kv.y + q.z * kv.z + q.w * kv.w;
                }
                s = acc;
            }
            sc[nsel * 64 + lane] = s;
            ++nsel;
        }
        for (int c = 0; c < 8; ++c) {
            int key = t - 511 + 64 * c + lane;
            float s = -INFINITY;
            if (key >= 0) {
                const float* kr = p.XW + (bbase + key) * INW + colKW;
                float acc = 0.f;
                for (int d = 0; d < 128; d += 4) {
                    float4 kv = *(const float4*)(kr + d);
                    float4 q = *(const float4*)&qs[d];
                    acc += q.x * kv.x + q.y * kv.y + q.z * kv.z + q.w * kv.w;
                }
                s = acc;
            }
            sc[1024 + c * 64 + lane] = s;
        }
        float m = -INFINITY;
        for (int i = 0; i < nsel; ++i) m = fmaxf(m, sc[i * 64 + lane]);
        m = wave_max(m);
        float l = 0.f;
        for (int i = 0; i < nsel; ++i) { float e = expf(sc[i * 64 + lane] - m); sc[i * 64 + lane] = e; l += e; }
        l = wave_sum(l);
        float inv_s = 1.0f / fmaxf(l, 1e-30f);
        float mw = -INFINITY;
        for (int c = 0; c < 8; ++c) mw = fmaxf(mw, sc[1024 + c * 64 + lane]);
        mw = wave_max(mw);
        float lw = 0.f;
        for (int c = 0; c < 8; ++c) { float e = expf(sc[1024 + c * 64 + lane] - mw); sc[1024 + c * 64 + lane] = e; lw += e; }
        lw = wave_sum(lw);
        float inv_w = 1.0f / fmaxf(lw, 1e-30f);
        __syncthreads();
        float os0 = 0.f, os1 = 0.f;
        {
            int i = 0;
            for (int j = 0; j <= cur; ++j) {
                if (!((mask >> j) & 1ull)) continue;
                int kend = min(64, t - 64 * j + 1);
                for (int kk = 0; kk < kend; ++kk) {
                    float pv = sc[i * 64 + kk];
                    const float* vr = p.XW + (bbase + 64 * j + kk) * INW + colVS;
                    os0 = fmaf(pv, vr[lane], os0);
                    os1 = fmaf(pv, vr[lane + 64], os1);
                }
                ++i;
            }
        }
        float ow0 = 0.f, ow1 = 0.f;
        {
            int kstart = max(0, 511 - t);
            for (int kk = kstart; kk < 512; ++kk) {
                float pv = sc[1024 + kk];
                const float* vr = p.XW + (bbase + (t - 511 + kk)) * INW + colVW;
                ow0 = fmaf(pv, vr[lane], ow0);
                ow1 = fmaf(pv, vr[lane + 64], ow1);
            }
        }
        float g0 = xrow[OFF_G + h * 3 + 0], g1 = xrow[OFF_G + h * 3 + 1], g2 = xrow[OFF_G + h * 3 + 2];
        const float* oc = p.OC + ((size_t)tok * 16 + h) * 128;
        float r0 = g0 * oc[lane] + g1 * os0 * inv_s + g2 * ow0 * inv_w;
        float r1 = g0 * oc[lane + 64] + g1 * os1 * inv_s + g2 * ow1 * inv_w;
        p.ONSA[(size_t)tok * 2048 + h * 128 + lane] = r0;
        p.ONSA[(size_t)tok * 2048 + h * 128 + 64 + lane] = r1;
    }
}

template <class Load>
__device__ void ln_rows(int nrows, Load load, const float* g, const float* bta, float* dst, float* smem) {
    const int tid = threadIdx.x;
    for (int r = blockIdx.x; r < nrows; r += gridDim.x) {
        float v[8]; float s = 0.f;
#pragma unroll
        for (int i = 0; i < 8; ++i) { v[i] = load(r, tid + 256 * i); s += v[i]; }
        float mu = block_sum(s, smem) * (1.0f / 2048.0f);
        float q = 0.f;
#pragma unroll
        for (int i = 0; i < 8; ++i) { float d = v[i] - mu; q += d * d; }
        float var = block_sum(q, smem) * (1.0f / 2048.0f);
        float rstd = rsqrtf(var + LN_EPS);
#pragma unroll
        for (int i = 0; i < 8; ++i) { int c = tid + 256 * i; dst[(size_t)r * 2048 + c] = (v[i] - mu) * rstd * g[c] + bta[c]; }
    }
}

__device__ void ph_sgu_ln(const Params& p, float* smem) {
    const float* XW = p.XW;
    ln_rows(NTOK, [=](int r, int c) { return XW[(size_t)r * INW + OFF_V + c]; }, p.sgu_ln_g, p.sgu_ln_b, p.VN, smem);
}

__device__ void ph_sgu_mix(const Params& p) {
    const int tid = threadIdx.x;
    for (int tok = blockIdx.x; tok < NTOK; tok += gridDim.x) {
        int tl = tok & 127; int base = tok - tl;
#pragma unroll 1
        for (int g = 0; g < 8; ++g) {
            const float* w = p.sgu_w_s + ((size_t)g * 128 + tl) * 128;
            float z = 0.f;
            for (int s = 0; s <= tl; ++s) z = fmaf(w[s], p.VN[(size_t)(base + s) * 2048 + g * 256 + tid], z);
            z += p.sgu_b_s[g * 128 + tl];
            int col = g * 256 + tid;
            p.OSGU[(size_t)tok * 2048 + col] = p.XW[(size_t)tok * INW + OFF_U + col] * z;
        }
    }
}

__device__ void ph_proj_a(const Params& p, float* smem) {
    float* MERGED = p.MERGED; const float* XW = p.XW;
    dense_gemm_phase(p.ONSA, 2048, p.w_branch_a, 2048, NTOK, 2048, 2048, smem,
                     [=](int r, int c, float v, float) { MERGED[(size_t)r * 2048 + c] = XW[(size_t)r * INW + OFF_GM + c] * v; });
}
__device__ void ph_proj_b(const Params& p, float* smem) {
    float* MERGED = p.MERGED; const float* XW = p.XW;
    dense_gemm_phase(p.OSGU, 2048, p.w_branch_b, 2048, NTOK, 2048, 2048, smem,
                     [=](int r, int c, float v, float) { MERGED[(size_t)r * 2048 + c] += XW[(size_t)r * INW + OFF_GM + 2048 + c] * v; });
}
__device__ void ph_wo(const Params& p, float* smem) {
    float* X1 = p.X1; const float* x = p.x;
    dense_gemm_phase(p.MERGED, 2048, p.w_o, 2048, NTOK, 2048, 2048, smem,
                     [=](int r, int c, float v, float) { X1[(size_t)r * 2048 + c] = DN_ALPHA * x[(size_t)r * 2048 + c] + v; });
}
__device__ void ph_ln1(const Params& p, float* smem) {
    const float* X1 = p.X1;
    ln_rows(NTOK, [=](int r, int c) { return X1[(size_t)r * 2048 + c]; }, p.ln1_g, p.ln1_b, p.X1, smem);
}
__device__ void ph_xq(const Params& p, float* smem) {
    float* QX = p.QX; float* KX = p.KX; float* VX = p.VX;
    dense_gemm_phase(p.X1, 2048, p.w_xq, MEMW, NTOK, MEMW, 2048, smem,
                     [=](int r, int c, float v, float) { QX[(size_t)r * MEMW + c] = v * QSCALE; });
    dense_gemm_phase(p.mem, 2048, p.w_xk, MEMW, BATCH * MEM_LEN, MEMW, 2048, smem,
                     [=](int r, int c, float v, float) { KX[(size_t)r * MEMW + c] = v; });
    dense_gemm_phase(p.mem, 2048, p.w_xv, MEMW, BATCH * MEM_LEN, MEMW, 2048, smem,
                     [=](int r, int c, float v, float) { VX[(size_t)r * MEMW + c] = v; });
}
__device__ void ph_xattn(const Params& p, float* smem) {
    const int tid = threadIdx.x, lane = tid & 63, wave = tid >> 6;
    float* qs = smem + wave * 384;
    float* ps = qs + 128;
    for (int u = blockIdx.x; u < NTOK; u += gridDim.x) {
        int tok = u, h = wave;
        int b = tok / SEQ;
        __syncthreads();
        qs[lane] = p.QX[(size_t)tok * MEMW + h * 128 + lane];
        qs[lane + 64] = p.QX[(size_t)tok * MEMW + h * 128 + 64 + lane];
        __syncthreads();
        float s4[4]; float m = -INFINITY;
#pragma unroll
        for (int i = 0; i < 4; ++i) {
            int key = lane + 64 * i;
            const float* kr = p.KX + (size_t)(b * MEM_LEN + key) * MEMW + h * 128;
            float acc = 0.f;
#pragma unroll 1
            for (int d = 0; d < 128; d += 4) {
                float4 kv = *(const float4*)(kr + d);
                float4 q = *(const float4*)&qs[d];
                acc += q.x * kv.x + q.y * kv.y + q.z * kv.z + q.w * kv.w;
            }
            s4[i] = acc; m = fmaxf(m, acc);
        }
        m = wave_max(m);
        float l = 0.f;
#pragma unroll
        for (int i = 0; i < 4; ++i) { s4[i] = expf(s4[i] - m); l += s4[i]; }
        l = wave_sum(l);
        float inv = 1.0f / l;
#pragma unroll
        for (int i = 0; i < 4; ++i) ps[lane + 64 * i] = s4[i] * inv;
        __syncthreads();
        float o0 = 0.f, o1 = 0.f;
        for (int key = 0; key < MEM_LEN; ++key) {
            const float* vr = p.VX + (size_t)(b * MEM_LEN + key) * MEMW + h * 128;
            float pv = ps[key];
            o0 = fmaf(pv, vr[lane], o0);
            o1 = fmaf(pv, vr[lane + 64], o1);
        }
        p.OX[(size_t)tok * MEMW + h * 128 + lane] = o0;
        p.OX[(size_t)tok * MEMW + h * 128 + 64 + lane] = o1;
    }
}
__device__ void ph_xo(const Params& p, float* smem) {
    float* X2 = p.X2; const float* X1 = p.X1;
    dense_gemm_phase(p.OX, MEMW, p.w_xo, 2048, NTOK, 2048, MEMW, smem,
                     [=](int r, int c, float v, float) { X2[(size_t)r * 2048 + c] = DN_ALPHA * X1[(size_t)r * 2048 + c] + v; });
}
__device__ void ph_ln2(const Params& p, float* smem) {
    const float* X2 = p.X2;
    ln_rows(NTOK, [=](int r, int c) { return X2[(size_t)r * 2048 + c]; }, p.ln2_g, p.ln2_b, p.X2, smem);
}
__device__ void ph_router(const Params& p) {
    const int tid = threadIdx.x, lane = tid & 63, wave = tid >> 6;
    for (int tok = blockIdx.x * 4 + wave; tok < NTOK; tok += gridDim.x * 4) {
        const float* xr = p.X2 + (size_t)tok * 2048;
        float le = 0.f, lg = 0.f;
        for (int d = 0; d < 2048; ++d) {
            float xv = xr[d];
            le = fmaf(xv, p.w_router_exp[(size_t)d * NEXP + lane], le);
            lg = fmaf(xv, p.w_router_grp[(size_t)d * 4 + (lane & 3)], lg);
        }
        le += p.b_router_exp[lane];
        lg += p.b_router_grp[lane & 3];
        float g0 = __shfl(lg, 0), g1 = __shfl(lg, 1), g2 = __shfl(lg, 2), g3 = __shfl(lg, 3);
        float gm = fmaxf(fmaxf(g0, g1), fmaxf(g2, g3));
        float e0 = expf(g0 - gm), e1 = expf(g1 - gm), e2 = expf(g2 - gm), e3 = expf(g3 - gm);
        float gs = e0 + e1 + e2 + e3;
        float p0 = e0 / gs, p1 = e1 / gs, p2 = e2 / gs, p3 = e3 / gs;
        int grp = 0; float pg = p0;
        if (p1 > pg) { pg = p1; grp = 1; }
        if (p2 > pg) { pg = p2; grp = 2; }
        if (p3 > pg) { pg = p3; grp = 3; }
        float lv[16];
#pragma unroll
        for (int i = 0; i < 16; ++i) lv[i] = __shfl(le, grp * 16 + i);
        float mx = lv[0];
#pragma unroll
        for (int i = 1; i < 16; ++i) mx = fmaxf(mx, lv[i]);
        float sum = 0.f;
#pragma unroll
        for (int i = 0; i < 16; ++i) { lv[i] = expf(lv[i] - mx); sum += lv[i]; }
        int i1 = 0; float v1 = lv[0];
#pragma unroll
        for (int i = 1; i < 16; ++i) if (lv[i] > v1) { v1 = lv[i]; i1 = i; }
        int i2 = -1; float v2 = -1.f;
#pragma unroll
        for (int i = 0; i < 16; ++i) if (i != i1 && lv[i] > v2) { v2 = lv[i]; i2 = i; }
        float pa = v1 / sum, pb = v2 / sum;
        float den = pa + pb;
        float w1 = pg * pa / den, w2 = pg * pb / den;
        if (lane == 0) {
            int ea = grp * 16 + i1, eb = grp * 16 + i2;
            int sa = atomicAdd(&p.CNT[ea], 1);
            p.LIST[ea * LISTCAP + sa] = tok * 2 + 0;
            int sb = atomicAdd(&p.CNT[eb], 1);
            p.LIST[eb * LISTCAP + sb] = tok * 2 + 1;
            p.WGT[tok * 2 + 0] = w1;
            p.WGT[tok * 2 + 1] = w2;
        }
    }
}
__device__ __forceinline__ bool moe_find_tile(const int* cnt, int mt, int& e, int& m0, int& mc) {
    for (int i = 0; i < NEXP; ++i) {
        int c = cnt[i]; int nt = (c + 63) >> 6;
        if (mt < nt) { e = i; m0 = mt * 64; mc = min(64, c - m0); return true; }
        mt -= nt;
    }
    return false;
}
__device__ void ph_moe_up(const Params& p, float* smem) {
    float* HB = p.HB; const int* LIST = p.LIST;
    const int MAXMT = (NTOK * 2) / 64 + NEXP;
    for (int u = blockIdx.x; u < MAXMT * (EFF / 64); u += gridDim.x) {
        int mt = u / (EFF / 64), nt = u % (EFF / 64);
        int e, m0, mc;
        if (!moe_find_tile(p.CNT, mt, e, m0, mc)) continue;
        const int* lst = LIST + e * LISTCAP;
        sgemm_tile<true>(p.X2, 2048, lst, 1, m0, mc, p.w_exp_gate + (size_t)e * 2048 * EFF, p.w_exp_up + (size_t)e * 2048 * EFF, EFF, nt * 64, EFF, 2048, smem,
                         [=](int r, int c, float v1, float v2) {
                             int a = lst[r];
                             float sl = v1 / (1.0f + expf(-v1));
                             HB[(size_t)a * EFF + c] = sl * v2;
                         });
    }
}
__device__ void ph_moe_down(const Params& p, float* smem) {
    float* Y = p.Y; const int* LIST = p.LIST; const float* WGT = p.WGT;
    const int MAXMT = (NTOK * 2) / 64 + NEXP;
    for (int u = blockIdx.x; u < MAXMT * (2048 / 64); u += gridDim.x) {
        int mt = u / 32, nt = u % 32;
        int e, m0, mc;
        if (!moe_find_tile(p.CNT, mt, e, m0, mc)) continue;
        const int* lst = LIST + e * LISTCAP;
        sgemm_tile<false>(p.HB, EFF, lst, 0, m0, mc, p.w_exp_down + (size_t)e * EFF * 2048, nullptr, 2048, nt * 64, 2048, EFF, smem,
                          [=](int r, int c, float v1, float) {
                              int a = lst[r];
                              Y[(size_t)a * 2048 + c] = v1 * WGT[a];
                          });
    }
}
__device__ void ph_final(const Params& p, float* smem) {
    const float* X2 = p.X2; const float* Y = p.Y;
    ln_rows(NTOK, [=](int r, int c) { return DN_ALPHA * X2[(size_t)r * 2048 + c] + Y[(size_t)(2 * r) * 2048 + c] + Y[(size_t)(2 * r + 1) * 2048 + c]; },
            p.ln3_g, p.ln3_b, p.out, smem);
}

constexpr int NPHASE = 18;

__global__ void __launch_bounds__(NTHR, 2) mega_kernel(Params p) {
    __shared__ __attribute__((aligned(16))) float smem[8192];
    cg::grid_group grid = cg::this_grid();
    const int lo = p.phase_lo, hi = p.phase_hi;
#define PH(k, body) if (lo <= (k) && (k) < hi) { body; if ((k) + 1 < hi) grid.sync(); }
    PH(0, ph_gemm_xw(p, smem))
    PH(1, ph_act(p))
    PH(2, ph_compress(p, smem); ph_sgu_ln(p, smem))
    PH(3, ph_cmp_attn(p, smem))
    PH(4, ph_nsa_main(p, smem))
    PH(5, ph_sgu_mix(p))
    PH(6, ph_proj_a(p, smem))
    PH(7, ph_proj_b(p, smem))
    PH(8, ph_wo(p, smem))
    PH(9, ph_ln1(p, smem))
    PH(10, ph_xq(p, smem))
    PH(11, ph_xattn(p, smem))
    PH(12, ph_xo(p, smem))
    PH(13, ph_ln2(p, smem))
    PH(14, ph_router(p))
    PH(15, ph_moe_up(p, smem))
    PH(16, ph_moe_down(p, smem))
    PH(17, ph_final(p, smem))
#undef PH
}

extern "C" void kernel_launch(void* const* d_in, const int* in_sizes, int n_in, void* d_out, int out_size, void* d_ws, size_t ws_size,
                              hipStream_t stream) {
    static int grid_blocks = 0;
    if (!grid_blocks) {
        int dev = 0, cus = 0, per_cu = 0;
        hipGetDevice(&dev);
        hipDeviceGetAttribute(&cus, hipDeviceAttributeMultiprocessorCount, dev);
        hipOccupancyMaxActiveBlocksPerMultiprocessor(&per_cu, mega_kernel, NTHR, 0);
        if (per_cu > 4) per_cu = 4;
        if (per_cu < 1) per_cu = 1;
        grid_blocks = cus * per_cu;
        fprintf(stderr, "kernel_launch: cus %d per_cu %d grid %d ws %zu\n", cus, per_cu, grid_blocks, ws_size);
    }
    Params p{};
    const float* const* in = (const float* const*)d_in;
    p.x = in[0]; p.mem = in[1]; p.w_in = in[2];
    p.cmp_pe_k = in[3]; p.cmp_w1_k = in[4]; p.cmp_w2_k = in[5];
    p.cmp_pe_v = in[6]; p.cmp_w1_v = in[7]; p.cmp_w2_v = in[8];
    p.sgu_ln_g = in[9]; p.sgu_ln_b = in[10]; p.sgu_w_s = in[11]; p.sgu_b_s = in[12];
    p.w_branch_a = in[13]; p.w_branch_b = in[14]; p.w_o = in[15]; p.ln1_g = in[16]; p.ln1_b = in[17];
    p.w_xq = in[18]; p.w_xk = in[19]; p.w_xv = in[20]; p.w_xo = in[21]; p.ln2_g = in[22]; p.ln2_b = in[23];
    p.w_router_grp = in[24]; p.b_router_grp = in[25]; p.w_router_exp = in[26]; p.b_router_exp = in[27];
    p.w_exp_gate = in[28]; p.w_exp_up = in[29]; p.w_exp_down = in[30]; p.ln3_g = in[31]; p.ln3_b = in[32];
    p.out = (float*)d_out;
    char* ws = (char*)d_ws; size_t off = 0;
    auto take = [&](size_t bytes) { char* r = ws + off; off += (bytes + 255) & ~(size_t)255; return r; };
    p.XW = (float*)take((size_t)NTOK * INW * 4);
    p.KC = (float*)take((size_t)BATCH * NCMP * 2 * 128 * 4);
    p.VC = (float*)take((size_t)BATCH * NCMP * 2 * 128 * 4);
    p.OC = (float*)take((size_t)NTOK * 2048 * 4);
    p.SELMASK = (unsigned long long*)take((size_t)NTOK * 2 * 8);
    p.ONSA = (float*)take((size_t)NTOK * 2048 * 4);
    p.VN = (float*)take((size_t)NTOK * 2048 * 4);
    p.OSGU = (float*)take((size_t)NTOK * 2048 * 4);
    p.MERGED = (float*)take((size_t)NTOK * 2048 * 4);
    p.X1 = (float*)take((size_t)NTOK * 2048 * 4);
    p.X2 = p.OC;
    p.QX = (float*)take((size_t)NTOK * MEMW * 4);
    p.KX = (float*)take((size_t)512 * MEMW * 4);
    p.VX = (float*)take((size_t)512 * MEMW * 4);
    p.OX = (float*)take((size_t)NTOK * MEMW * 4);
    p.CNT = (int*)take(64 * 4);
    p.LIST = (int*)take((size_t)NEXP * LISTCAP * 4);
    p.WGT = (float*)take((size_t)NTOK * 2 * 4);
    p.HB = p.XW;
    p.Y = p.XW + (size_t)NTOK * 2 * EFF;
    if (off > ws_size) { fprintf(stderr, "kernel_launch: workspace too small: need %zu have %zu\n", off, ws_size); return; }
#if MK_MULTI
    for (int ph = 0; ph < NPHASE; ++ph) {
        p.phase_lo = ph; p.phase_hi = ph + 1;
        hipLaunchKernelGGL(mega_kernel, dim3(grid_blocks), dim3(NTHR), 0, stream, p);
    }
#else
    p.phase_lo = 0; p.phase_hi = NPHASE;
    void* args[] = {&p};
    hipError_t e = hipLaunchCooperativeKernel((void*)mega_kernel, dim3(grid_blocks), dim3(NTHR), args, 0, stream);
    if (e != hipSuccess) fprintf(stderr, "cooperative launch failed: %s (grid %d)\n", hipGetErrorString(e), grid_blocks);
#endif
}
```

```cpp
#include <hip/hip_runtime.h>
#include <hip/hip_cooperative_groups.h>
#include <stdint.h>
#include <cstdio>
namespace cg = cooperative_groups;

#ifndef MK_MULTI
#define MK_MULTI 0
#endif

constexpr int D_MODEL = 2048, BATCH = 2, SEQ = 4096, NTOK = BATCH * SEQ;
constexpr int HD = 128, NH = 16, NG = 2, HPG = 8;
constexpr int NCMP = 255;
constexpr int INW = 11824;
constexpr int OFF_Q = 0, OFF_KV = 2048, OFF_G = 3584, OFF_U = 3632, OFF_V = 5680, OFF_GM = 7728;
constexpr int MEM_LEN = 256, MEMW = 512;
constexpr int NEXP = 64, EFF = 512;
constexpr int LISTCAP = 8192;
constexpr float DN_ALPHA = 1.189207115002721f;
constexpr float LN_EPS = 1e-5f;
constexpr float QSCALE = 0.08838834764831845f;
constexpr int NTHR = 256;

struct Params {
    const float* x; const float* mem; const float* w_in;
    const float* cmp_pe_k; const float* cmp_w1_k; const float* cmp_w2_k;
    const float* cmp_pe_v; const float* cmp_w1_v; const float* cmp_w2_v;
    const float* sgu_ln_g; const float* sgu_ln_b; const float* sgu_w_s; const float* sgu_b_s;
    const float* w_branch_a; const float* w_branch_b; const float* w_o; const float* ln1_g; const float* ln1_b;
    const float* w_xq; const float* w_xk; const float* w_xv; const float* w_xo; const float* ln2_g; const float* ln2_b;
    const float* w_router_grp; const float* b_router_grp; const float* w_router_exp; const float* b_router_exp;
    const float* w_exp_gate; const float* w_exp_up; const float* w_exp_down; const float* ln3_g; const float* ln3_b;
    float* out;
    float* XW;
    float* KC;
    float* VC;
    float* OC;
    unsigned long long* SELMASK;
    float* ONSA;
    float* VN;
    float* OSGU;
    float* MERGED;
    float* X1;
    float* X2;
    float* QX;
    float* KX;
    float* VX;
    float* OX;
    int* CNT;
    int* LIST;
    float* WGT;
    float* HB;
    float* Y;
    int phase_lo; int phase_hi;
};

__device__ __forceinline__ float gelu_tanh(float x) {
    const float k0 = 0.7978845608028654f, k1 = 0.044715f;
    float inner = k0 * (x + k1 * x * x * x);
    return 0.5f * x * (1.0f + tanhf(inner));
}
__device__ __forceinline__ float sigmoidf_(float x) { return 1.0f / (1.0f + expf(-x)); }

__device__ __forceinline__ float wave_sum(float v) {
#pragma unroll
    for (int o = 32; o > 0; o >>= 1) v += __shfl_xor(v, o);
    return v;
}
__device__ __forceinline__ float wave_max(float v) {
#pragma unroll
    for (int o = 32; o > 0; o >>= 1) v = fmaxf(v, __shfl_xor(v, o));
    return v;
}
__device__ __forceinline__ float block_sum(float v, float* red) {
    v = wave_sum(v);
    __syncthreads();
    if ((threadIdx.x & 63) == 0) red[threadIdx.x >> 6] = v;
    __syncthreads();
    float r = red[0] + red[1] + red[2] + red[3];
    return r;
}

template <bool DUAL, class Epi>
__device__ __forceinline__ void sgemm_tile(const float* __restrict__ A, int lda, const int* __restrict__ arow, int ashift,
                                           int m0, int mcount,
                                           const float* __restrict__ B, const float* __restrict__ B2, int ldb, int n0, int N, int K,
                                           float* smem, Epi epi) {
    float* As = smem;
    float* Bs = smem + 16 * 68;
    float* Bs2 = Bs + 16 * 64;
    const int tid = threadIdx.x;
    const int tx = tid & 15, ty = tid >> 4;
    const int ar = tid >> 2, ak = (tid & 3) * 4;
    const int bk = tid >> 4, bn = (tid & 15) * 4;
    const float* aptr = nullptr;
    if (ar < mcount) {
        int src = arow ? (arow[m0 + ar] >> ashift) : (m0 + ar);
        aptr = A + (size_t)src * lda + ak;
    }
    const bool bvalid = (n0 + bn) < N;
    const float* bptr = B + (size_t)bk * ldb + n0 + bn;
    const float* bptr2 = DUAL ? (B2 + (size_t)bk * ldb + n0 + bn) : nullptr;
    float acc[4][4], acc2[4][4];
#pragma unroll
    for (int i = 0; i < 4; ++i)
#pragma unroll
        for (int j = 0; j < 4; ++j) { acc[i][j] = 0.f; acc2[i][j] = 0.f; }
    for (int k0 = 0; k0 < K; k0 += 16) {
        float4 av = make_float4(0.f, 0.f, 0.f, 0.f), bv = av, bv2 = av;
        if (aptr) av = *(const float4*)(aptr + k0);
        if (bvalid) {
            bv = *(const float4*)(bptr + (size_t)k0 * ldb);
            if (DUAL) bv2 = *(const float4*)(bptr2 + (size_t)k0 * ldb);
        }
        __syncthreads();
        As[(ak + 0) * 68 + ar] = av.x; As[(ak + 1) * 68 + ar] = av.y; As[(ak + 2) * 68 + ar] = av.z; As[(ak + 3) * 68 + ar] = av.w;
        *(float4*)&Bs[bk * 64 + bn] = bv;
        if (DUAL) *(float4*)&Bs2[bk * 64 + bn] = bv2;
        __syncthreads();
#pragma unroll
        for (int kk = 0; kk < 16; ++kk) {
            float4 a = *(const float4*)&As[kk * 68 + ty * 4];
            float4 b = *(const float4*)&Bs[kk * 64 + tx * 4];
            float a4[4] = {a.x, a.y, a.z, a.w};
            float b4[4] = {b.x, b.y, b.z, b.w};
#pragma unroll
            for (int i = 0; i < 4; ++i)
#pragma unroll
                for (int j = 0; j < 4; ++j) acc[i][j] = fmaf(a4[i], b4[j], acc[i][j]);
            if (DUAL) {
                float4 c = *(const float4*)&Bs2[kk * 64 + tx * 4];
                float c4[4] = {c.x, c.y, c.z, c.w};
#pragma unroll
                for (int i = 0; i < 4; ++i)
#pragma unroll
                    for (int j = 0; j < 4; ++j) acc2[i][j] = fmaf(a4[i], c4[j], acc2[i][j]);
            }
        }
    }
#pragma unroll
    for (int i = 0; i < 4; ++i) {
        int r = ty * 4 + i;
        if (r < mcount) {
#pragma unroll
            for (int j = 0; j < 4; ++j) {
                int c = n0 + tx * 4 + j;
                if (c < N) epi(m0 + r, c, acc[i][j], acc2[i][j]);
            }
        }
    }
    __syncthreads();
}

template <class Epi>
__device__ void dense_gemm_phase(const float* A, int lda, const float* B, int ldb, int M, int N, int K, float* smem, Epi epi) {
    const int mt = (M + 63) / 64, nt = (N + 63) / 64;
    for (int u = blockIdx.x; u < mt * nt; u += gridDim.x) {
        int tm = u % mt, tn = u / mt;
        int m0 = tm * 64; int mc = min(64, M - m0);
        sgemm_tile<false>(A, lda, nullptr, 0, m0, mc, B, nullptr, ldb, tn * 64, N, K, smem, epi);
    }
}

__device__ void ph_gemm_xw(const Params& p, float* smem) {
    if (blockIdx.x == 0 && threadIdx.x < NEXP) p.CNT[threadIdx.x] = 0;
    float* XW = p.XW;
    dense_gemm_phase(p.x, D_MODEL, p.w_in, INW, NTOK, INW, D_MODEL, smem,
                     [=](int r, int c, float v, float) { XW[(size_t)r * INW + c] = v; });
}

__device__ __forceinline__ void rope_angles(int pos, int d, float& c, float& s) {
    float inv = powf(10000.0f, -(float)(2 * d) / 128.0f);
    float ang = (float)pos * inv;
    c = cosf(ang); s = sinf(ang);
}

__device__ void ph_act(const Params& p) {
    const size_t total = (size_t)NTOK * INW;
    for (size_t idx = (size_t)blockIdx.x * NTHR + threadIdx.x; idx < total; idx += (size_t)gridDim.x * NTHR) {
        int tok = (int)(idx / INW), col = (int)(idx % INW);
        int pos = tok % SEQ;
        float* row = p.XW + (size_t)tok * INW;
        if (col < OFF_KV) {
            int d = col & 127;
            if (d < 64) {
                float c, s; rope_angles(pos, d, c, s);
                float t1 = row[col], t2 = row[col + 64];
                row[col] = (t1 * c - t2 * s) * QSCALE;
                row[col + 64] = (t1 * s + t2 * c) * QSCALE;
            }
        } else if (col < OFF_G) {
            int ch = (col - OFF_KV) >> 7; int d = col & 127;
            bool rp = (ch == 4 || ch == 5 || ch == 8 || ch == 9);
            if (rp && d < 64) {
                float c, s; rope_angles(pos, d, c, s);
                float t1 = row[col], t2 = row[col + 64];
                row[col] = t1 * c - t2 * s;
                row[col + 64] = t1 * s + t2 * c;
            }
        } else if (col < OFF_U) {
            row[col] = sigmoidf_(row[col]);
        } else if (col < OFF_GM) {
            row[col] = gelu_tanh(row[col]);
        } else {
            row[col] = sigmoidf_(row[col]);
        }
    }
}

__device__ void ph_compress(const Params& p, float* smem) {
    float* a = smem;
    float* hid = smem + 4096;
    float* o = hid + 256;
    const int tid = threadIdx.x;
    for (int u = blockIdx.x; u < BATCH * NCMP * 4; u += gridDim.x) {
        int kvsel = u & 1, g = (u >> 1) & 1, bi = u >> 2;
        int b = bi / NCMP, i = bi % NCMP;
        const float* pe = kvsel ? p.cmp_pe_v : p.cmp_pe_k;
        const float* w1 = kvsel ? p.cmp_w1_v : p.cmp_w1_k;
        const float* w2 = kvsel ? p.cmp_w2_v : p.cmp_w2_k;
        __syncthreads();
        for (int e = tid; e < 4096; e += NTHR) {
            int pp = e >> 7, d = e & 127;
            a[e] = p.XW[(size_t)(b * SEQ + 16 * i + pp) * INW + OFF_KV + (kvsel * 2 + g) * 128 + d] + pe[e];
        }
        __syncthreads();
        float acc = 0.f;
        for (int k = 0; k < 4096; ++k) acc = fmaf(a[k], w1[(size_t)k * 256 + tid], acc);
        hid[tid] = gelu_tanh(acc);
        __syncthreads();
        if (tid < 128) {
            float s = 0.f;
            for (int n = 0; n < 256; ++n) s = fmaf(hid[n], w2[n * 128 + tid], s);
            o[tid] = s;
        }
        __syncthreads();
        float* dst = (kvsel ? p.VC : p.KC) + (size_t)((b * NCMP + i) * 2 + g) * 128;
        if (kvsel) {
            if (tid < 128) dst[tid] = o[tid];
        } else if (tid < 64) {
            float c, s; rope_angles(16 * i + 31, tid, c, s);
            float t1 = o[tid], t2 = o[tid + 64];
            dst[tid] = t1 * c - t2 * s;
            dst[tid + 64] = t1 * s + t2 * c;
        }
    }
}

__device__ void ph_cmp_attn(const Params& p, float* smem) {
    float* qs = smem;
    float* S = smem + 1024;
    float* Psum = S + 2048;
    float* sc = Psum + 256;
    const int tid = threadIdx.x, lane = tid & 63, wave = tid >> 6;
    for (int u = blockIdx.x; u < NTOK * 2; u += gridDim.x) {
        int tok = u >> 1, g = u & 1;
        int b = tok / SEQ, t = tok % SEQ;
        int nvalid = (t >= 31) ? ((t - 31) / 16 + 1) : 0;
        if (nvalid > NCMP) nvalid = NCMP;
        __syncthreads();
        for (int e = tid; e < 1024; e += NTHR) qs[e] = p.XW[(size_t)tok * INW + g * 1024 + e];
        __syncthreads();
        {
            int k = tid;
            float s8[8];
#pragma unroll
            for (int n = 0; n < 8; ++n) s8[n] = 0.f;
            if (k < nvalid) {
                const float* kr = p.KC + (size_t)((b * NCMP + k) * 2 + g) * 128;
                for (int d = 0; d < 128; d += 4) {
                    float4 kv = *(const float4*)(kr + d);
#pragma unroll
                    for (int n = 0; n < 8; ++n) {
                        float4 q = *(const float4*)&qs[n * 128 + d];
                        s8[n] += q.x * kv.x + q.y * kv.y + q.z * kv.z + q.w * kv.w;
                    }
                }
            }
#pragma unroll
            for (int n = 0; n < 8; ++n) S[n * 256 + k] = (k < nvalid) ? s8[n] : -INFINITY;
        }
        __syncthreads();
#pragma unroll
        for (int hh = 0; hh < 2; ++hh) {
            int n = wave * 2 + hh;
            float v[4]; float m = -INFINITY;
#pragma unroll
            for (int i = 0; i < 4; ++i) { v[i] = S[n * 256 + lane + 64 * i]; m = fmaxf(m, v[i]); }
            m = wave_max(m);
            float sum = 0.f;
            if (nvalid > 0) {
#pragma unroll
                for (int i = 0; i < 4; ++i) { v[i] = expf(v[i] - m); sum += v[i]; }
            } else {
#pragma unroll
                for (int i = 0; i < 4; ++i) v[i] = 0.f;
            }
            sum = wave_sum(sum);
            float inv = 1.0f / fmaxf(sum, 1e-30f);
#pragma unroll
            for (int i = 0; i < 4; ++i) S[n * 256 + lane + 64 * i] = v[i] * inv;
        }
        __syncthreads();
        {
            int d = tid & 127, n0 = tid >> 7;
            float o4[4] = {0.f, 0.f, 0.f, 0.f};
            for (int k = 0; k < nvalid; ++k) {
                float vv = p.VC[(size_t)((b * NCMP + k) * 2 + g) * 128 + d];
#pragma unroll
                for (int r = 0; r < 4; ++r) o4[r] = fmaf(S[(n0 + 2 * r) * 256 + k], vv, o4[r]);
            }
#pragma unroll
            for (int r = 0; r < 4; ++r) p.OC[((size_t)tok * 16 + g * 8 + n0 + 2 * r) * 128 + d] = o4[r];
        }
        {
            float ps = 0.f;
#pragma unroll
            for (int n = 0; n < 8; ++n) ps += S[n * 256 + tid];
            Psum[tid] = ps;
        }
        __syncthreads();
        const int cur = t / 64;
        if (tid < 64) {
            int j = tid;
            float imp = 0.f;
            int k0 = 4 * j;
            if (k0 - 1 >= 0) imp += 0.5f * Psum[k0 - 1];
            imp += Psum[k0];
            imp += Psum[k0 + 1];
            imp += Psum[k0 + 2];
            if (k0 + 3 < NCMP) imp += 0.5f * Psum[k0 + 3];
            bool forced = (j == 0) || (j == cur) || (j == cur - 1);
            bool visible = j <= cur;
            sc[j] = forced ? 1e9f : (visible ? imp : -1e9f);
        }
        __syncthreads();
        if (tid < 64) {
            int j = tid; float me = sc[j]; int rank = 0;
            for (int jj = 0; jj < 64; ++jj) {
                float o = sc[jj];
                rank += (o > me || (o == me && jj < j)) ? 1 : 0;
            }
            unsigned long long m = __ballot(rank < 16);
            if (tid == 0) p.SELMASK[u] = m;
        }
    }
}

__device__ void ph_nsa_main(const Params& p, float* smem) {
    const int tid = threadIdx.x, lane = tid & 63, wave = tid >> 6;
    float* qs = smem + wave * 1664;
    float* sc = qs + 128;
    for (int u = blockIdx.x; u < NTOK * 4; u += gridDim.x) {
        int tok = u >> 2, hq = u & 3;
        int h = hq * 4 + wave, g = h >> 3;
        int b = tok / SEQ, t = tok % SEQ;
        const int cur = t / 64;
        unsigned long long mask = p.SELMASK[tok * 2 + g];
        const float* xrow = p.XW + (size_t)tok * INW;
        __syncthreads();
        qs[lane] = xrow[h * 128 + lane];
        qs[lane + 64] = xrow[h * 128 + 64 + lane];
        __syncthreads();
        const size_t bbase = (size_t)b * SEQ;
        const int colKS = OFF_KV + (4 + g) * 128, colVS = OFF_KV + (6 + g) * 128, colKW = OFF_KV + (8 + g) * 128, colVW = OFF_KV + (10 + g) * 128;
        int nsel = 0;
        for (int j = 0; j <= cur; ++j) {
            if (!((mask >> j) & 1ull)) continue;
            int key = 64 * j + lane;
            float s = -INFINITY;
            if (key <= t) {
                const float* kr = p.XW + (bbase + key) * INW + colKS;
                float acc = 0.f;
                for (int d = 0; d < 128; d += 4) {
                    float4 kv = *(const float4*)(kr + d);
                    float4 q = *(const float4*)&qs[d];
                    acc += q.x * kv.x + q.y * kv.y + q.z * kv.z + q.w * kv.w;
                }
                s = acc;
            }
            sc[nsel * 64 + lane] = s;
            ++nsel;
        }
        for (int c = 0; c < 8; ++c) {
            int key = t - 511 + 64 * c + lane;
            float s = -INFINITY;
            if (key >= 0) {
                const float* kr = p.XW + (bbase + key) * INW + colKW;
                float acc = 0.f;
                for (int d = 0; d < 128; d += 4) {
                    float4 kv = *(const float4*)(kr + d);
                    float4 q = *(const float4*)&qs[d];
                    acc += q.x * kv.x + q.y * kv.y + q.z * kv.z + q.w * kv.w;
                }
                s = acc;
            }
            sc[1024 + c * 64 + lane] = s;
        }
        float m = -INFINITY;
        for (int i = 0; i < nsel; ++i) m = fmaxf(m, sc[i * 64 + lane]);
        m = wave_max(m);
        float l = 0.f;
        for (int i = 0; i < nsel; ++i) { float e = expf(sc[i * 64 + lane] - m); sc[i * 64 + lane] = e; l += e; }
        l = wave_sum(l);
        float inv_s = 1.0f / fmaxf(l, 1e-30f);
        float mw = -INFINITY;
        for (int c = 0; c < 8; ++c) mw = fmaxf(mw, sc[1024 + c * 64 + lane]);
        mw = wave_max(mw);
        float lw = 0.f;
        for (int c = 0; c < 8; ++c) { float e = expf(sc[1024 + c * 64 + lane] - mw); sc[1024 + c * 64 + lane] = e; lw += e; }
        lw = wave_sum(lw);
        float inv_w = 1.0f / fmaxf(lw, 1e-30f);
        __syncthreads();
        float os0 = 0.f, os1 = 0.f;
        {
            int i = 0;
            for (int j = 0; j <= cur; ++j) {
                if (!((mask >> j) & 1ull)) continue;
                int kend = min(64, t - 64 * j + 1);
                for (int kk = 0; kk < kend; ++kk) {
                    float pv = sc[i * 64 + kk];
                    const float* vr = p.XW + (bbase + 64 * j + kk) * INW + colVS;
                    os0 = fmaf(pv, vr[lane], os0);
                    os1 = fmaf(pv, vr[lane + 64], os1);
                }
                ++i;
            }
        }
        float ow0 = 0.f, ow1 = 0.f;
        {
            int kstart = max(0, 511 - t);
            for (int kk = kstart; kk < 512; ++kk) {
                float pv = sc[1024 + kk];
                const float* vr = p.XW + (bbase + (t - 511 + kk)) * INW + colVW;
                ow0 = fmaf(pv, vr[lane], ow0);
                ow1 = fmaf(pv, vr[lane + 64], ow1);
            }
        }
        float g0 = xrow[OFF_G + h * 3 + 0], g1 = xrow[OFF_G + h * 3 + 1], g2 = xrow[OFF_G + h * 3 + 2];
        const float* oc = p.OC + ((size_t)tok * 16 + h) * 128;
        float r0 = g0 * oc[lane] + g1 * os0 * inv_s + g2 * ow0 * inv_w;
        float r1 = g0 * oc[lane + 64] + g1 * os1 * inv_s + g2 * ow1 * inv_w;
        p.ONSA[(size_t)tok * 2048 + h * 128 + lane] = r0;
        p.ONSA[(size_t)tok * 2048 + h * 128 + 64 + lane] = r1;
    }
}

template <class Load>
__device__ void ln_rows(int nrows, Load load, const float* g, const float* bta, float* dst, float* smem) {
    const int tid = threadIdx.x;
    for (int r = blockIdx.x; r < nrows; r += gridDim.x) {
        float v[8]; float s = 0.f;
#pragma unroll
        for (int i = 0; i < 8; ++i) { v[i] = load(r, tid + 256 * i); s += v[i]; }
        float mu = block_sum(s, smem) * (1.0f / 2048.0f);
        float q = 0.f;
#pragma unroll
        for (int i = 0; i < 8; ++i) { float d = v[i] - mu; q += d * d; }
        float var = block_sum(q, smem) * (1.0f / 2048.0f);
        float rstd = rsqrtf(var + LN_EPS);
#pragma unroll
        for (int i = 0; i < 8; ++i) { int c = tid + 256 * i; dst[(size_t)r * 2048 + c] = (v[i] - mu) * rstd * g[c] + bta[c]; }
    }
}

__device__ void ph_sgu_ln(const Params& p, float* smem) {
    const float* XW = p.XW;
    ln_rows(NTOK, [=](int r, int c) { return XW[(size_t)r * INW + OFF_V + c]; }, p.sgu_ln_g, p.sgu_ln_b, p.VN, smem);
}

__device__ void ph_sgu_mix(const Params& p) {
    const int tid = threadIdx.x;
    for (int tok = blockIdx.x; tok < NTOK; tok += gridDim.x) {
        int tl = tok & 127; int base = tok - tl;
#pragma unroll 1
        for (int g = 0; g < 8; ++g) {
            const float* w = p.sgu_w_s + ((size_t)g * 128 + tl) * 128;
            float z = 0.f;
            for (int s = 0; s <= tl; ++s) z = fmaf(w[s], p.VN[(size_t)(base + s) * 2048 + g * 256 + tid], z);
            z += p.sgu_b_s[g * 128 + tl];
            int col = g * 256 + tid;
            p.OSGU[(size_t)tok * 2048 + col] = p.XW[(size_t)tok * INW + OFF_U + col] * z;
        }
    }
}

__device__ void ph_proj_a(const Params& p, float* smem) {
    float* MERGED = p.MERGED; const float* XW = p.XW;
    dense_gemm_phase(p.ONSA, 2048, p.w_branch_a, 2048, NTOK, 2048, 2048, smem,
                     [=](int r, int c, float v, float) { MERGED[(size_t)r * 2048 + c] = XW[(size_t)r * INW + OFF_GM + c] * v; });
}
__device__ void ph_proj_b(const Params& p, float* smem) {
    float* MERGED = p.MERGED; const float* XW = p.XW;
    dense_gemm_phase(p.OSGU, 2048, p.w_branch_b, 2048, NTOK, 2048, 2048, smem,
                     [=](int r, int c, float v, float) { MERGED[(size_t)r * 2048 + c] += XW[(size_t)r * INW + OFF_GM + 2048 + c] * v; });
}
__device__ void ph_wo(const Params& p, float* smem) {
    float* X1 = p.X1; const float* x = p.x;
    dense_gemm_phase(p.MERGED, 2048, p.w_o, 2048, NTOK, 2048, 2048, smem,
                     [=](int r, int c, float v, float) { X1[(size_t)r * 2048 + c] = DN_ALPHA * x[(size_t)r * 2048 + c] + v; });
}
__device__ void ph_ln1(const Params& p, float* smem) {
    const float* X1 = p.X1;
    ln_rows(NTOK, [=](int r, int c) { return X1[(size_t)r * 2048 + c]; }, p.ln1_g, p.ln1_b, p.X1, smem);
}
__device__ void ph_xq(const Params& p, float* smem) {
    float* QX = p.QX; float* KX = p.KX; float* VX = p.VX;
    dense_gemm_phase(p.X1, 2048, p.w_xq, MEMW, NTOK, MEMW, 2048, smem,
                     [=](int r, int c, float v, float) { QX[(size_t)r * MEMW + c] = v * QSCALE; });
    dense_gemm_phase(p.mem, 2048, p.w_xk, MEMW, BATCH * MEM_LEN, MEMW, 2048, smem,
                     [=](int r, int c, float v, float) { KX[(size_t)r * MEMW + c] = v; });
    dense_gemm_phase(p.mem, 2048, p.w_xv, MEMW, BATCH * MEM_LEN, MEMW, 2048, smem,
                     [=](int r, int c, float v, float) { VX[(size_t)r * MEMW + c] = v; });
}
__device__ void ph_xattn(const Params& p, float* smem) {
    const int tid = threadIdx.x, lane = tid & 63, wave = tid >> 6;
    float* qs = smem + wave * 384;
    float* ps = qs + 128;
    for (int u = blockIdx.x; u < NTOK; u += gridDim.x) {
        int tok = u, h = wave;
        int b = tok / SEQ;
        __syncthreads();
        qs[lane] = p.QX[(size_t)tok * MEMW + h * 128 + lane];
        qs[lane + 64] = p.QX[(size_t)tok * MEMW + h * 128 + 64 + lane];
        __syncthreads();
        float s4[4]; float m = -INFINITY;
#pragma unroll
        for (int i = 0; i < 4; ++i) {
            int key = lane + 64 * i;
            const float* kr = p.KX + (size_t)(b * MEM_LEN + key) * MEMW + h * 128;
            float acc = 0.f;
#pragma unroll 1
            for (int d = 0; d < 128; d += 4) {
                float4 kv = *(const float4*)(kr + d);
                float4 q = *(const float4*)&qs[d];
                acc += q.x * kv.x + q.y * kv.y + q.z * kv.z + q.w * kv.w;
            }
            s4[i] = acc; m = fmaxf(m, acc);
        }
        m = wave_max(m);
        float l = 0.f;
#pragma unroll
        for (int i = 0; i < 4; ++i) { s4[i] = expf(s4[i] - m); l += s4[i]; }
        l = wave_sum(l);
        float inv = 1.0f / l;
#pragma unroll
        for (int i = 0; i < 4; ++i) ps[lane + 64 * i] = s4[i] * inv;
        __syncthreads();
        float o0 = 0.f, o1 = 0.f;
        for (int key = 0; key < MEM_LEN; ++key) {
            const float* vr = p.VX + (size_t)(b * MEM_LEN + key) * MEMW + h * 128;
            float pv = ps[key];
            o0 = fmaf(pv, vr[lane], o0);
            o1 = fmaf(pv, vr[lane + 64], o1);
        }
        p.OX[(size_t)tok * MEMW + h * 128 + lane] = o0;
        p.OX[(size_t)tok * MEMW + h * 128 + 64 + lane] = o1;
    }
}
__device__ void ph_xo(const Params& p, float* smem) {
    float* X2 = p.X2; const float* X1 = p.X1;
    dense_gemm_phase(p.OX, MEMW, p.w_xo, 2048, NTOK, 2048, MEMW, smem,
                     [=](int r, int c, float v, float) { X2[(size_t)r * 2048 + c] = DN_ALPHA * X1[(size_t)r * 2048 + c] + v; });
}
__device__ void ph_ln2(const Params& p, float* smem) {
    const float* X2 = p.X2;
    ln_rows(NTOK, [=](int r, int c) { return X2[(size_t)r * 2048 + c]; }, p.ln2_g, p.ln2_b, p.X2, smem);
}
__device__ void ph_router(const Params& p) {
    const int tid = threadIdx.x, lane = tid & 63, wave = tid >> 6;
    for (int tok = blockIdx.x * 4 + wave; tok < NTOK; tok += gridDim.x * 4) {
        const float* xr = p.X2 + (size_t)tok * 2048;
        float le = 0.f, lg = 0.f;
        for (int d = 0; d < 2048; ++d) {
            float xv = xr[d];
            le = fmaf(xv, p.w_router_exp[(size_t)d * NEXP + lane], le);
            lg = fmaf(xv, p.w_router_grp[(size_t)d * 4 + (lane & 3)], lg);
        }
        le += p.b_router_exp[lane];
        lg += p.b_router_grp[lane & 3];
        float g0 = __shfl(lg, 0), g1 = __shfl(lg, 1), g2 = __shfl(lg, 2), g3 = __shfl(lg, 3);
        float gm = fmaxf(fmaxf(g0, g1), fmaxf(g2, g3));
        float e0 = expf(g0 - gm), e1 = expf(g1 - gm), e2 = expf(g2 - gm), e3 = expf(g3 - gm);
        float gs = e0 + e1 + e2 + e3;
        float p0 = e0 / gs, p1 = e1 / gs, p2 = e2 / gs, p3 = e3 / gs;
        int grp = 0; float pg = p0;
        if (p1 > pg) { pg = p1; grp = 1; }
        if (p2 > pg) { pg = p2; grp = 2; }
        if (p3 > pg) { pg = p3; grp = 3; }
        float lv[16];
#pragma unroll
        for (int i = 0; i < 16; ++i) lv[i] = __shfl(le, grp * 16 + i);
        float mx = lv[0];
#pragma unroll
        for (int i = 1; i < 16; ++i) mx = fmaxf(mx, lv[i]);
        float sum = 0.f;
#pragma unroll
        for (int i = 0; i < 16; ++i) { lv[i] = expf(lv[i] - mx); sum += lv[i]; }
        int i1 = 0; float v1 = lv[0];
#pragma unroll
        for (int i = 1; i < 16; ++i) if (lv[i] > v1) { v1 = lv[i]; i1 = i; }
        int i2 = -1; float v2 = -1.f;
#pragma unroll
        for (int i = 0; i < 16; ++i) if (i != i1 && lv[i] > v2) { v2 = lv[i]; i2 = i; }
        float pa = v1 / sum, pb = v2 / sum;
        float den = pa + pb;
        float w1 = pg * pa / den, w2 = pg * pb / den;
        if (lane == 0) {
            int ea = grp * 16 + i1, eb = grp * 16 + i2;
            int sa = atomicAdd(&p.CNT[ea], 1);
            p.LIST[ea * LISTCAP + sa] = tok * 2 + 0;
            int sb = atomicAdd(&p.CNT[eb], 1);
            p.LIST[eb * LISTCAP + sb] = tok * 2 + 1;
            p.WGT[tok * 2 + 0] = w1;
            p.WGT[tok * 2 + 1] = w2;
        }
    }
}
__device__ __forceinline__ bool moe_find_tile(const int* cnt, int mt, int& e, int& m0, int& mc) {
    for (int i = 0; i < NEXP; ++i) {
        int c = cnt[i]; int nt = (c + 63) >> 6;
        if (mt < nt) { e = i; m0 = mt * 64; mc = min(64, c - m0); return true; }
        mt -= nt;
    }
    return false;
}
__device__ void ph_moe_up(const Params& p, float* smem) {
    float* HB = p.HB; const int* LIST = p.LIST;
    const int MAXMT = (NTOK * 2) / 64 + NEXP;
    for (int u = blockIdx.x; u < MAXMT * (EFF / 64); u += gridDim.x) {
        int mt = u / (EFF / 64), nt = u % (EFF / 64);
        int e, m0, mc;
        if (!moe_find_tile(p.CNT, mt, e, m0, mc)) continue;
        const int* lst = LIST + e * LISTCAP;
        sgemm_tile<true>(p.X2, 2048, lst, 1, m0, mc, p.w_exp_gate + (size_t)e * 2048 * EFF, p.w_exp_up + (size_t)e * 2048 * EFF, EFF, nt * 64, EFF, 2048, smem,
                         [=](int r, int c, float v1, float v2) {
                             int a = lst[r];
                             float sl = v1 / (1.0f + expf(-v1));
                             HB[(size_t)a * EFF + c] = sl * v2;
                         });
    }
}
__device__ void ph_moe_down(const Params& p, float* smem) {
    float* Y = p.Y; const int* LIST = p.LIST; const float* WGT = p.WGT;
    const int MAXMT = (NTOK * 2) / 64 + NEXP;
    for (int u = blockIdx.x; u < MAXMT * (2048 / 64); u += gridDim.x) {
        int mt = u / 32, nt = u % 32;
        int e, m0, mc;
        if (!moe_find_tile(p.CNT, mt, e, m0, mc)) continue;
        const int* lst = LIST + e * LISTCAP;
        sgemm_tile<false>(p.HB, EFF, lst, 0, m0, mc, p.w_exp_down + (size_t)e * EFF * 2048, nullptr, 2048, nt * 64, 2048, EFF, smem,
                          [=](int r, int c, float v1, float) {
                              int a = lst[r];
                              Y[(size_t)a * 2048 + c] = v1 * WGT[a];
                          });
    }
}
__device__ void ph_final(const Params& p, float* smem) {
    const float* X2 = p.X2; const float* Y = p.Y;
    ln_rows(NTOK, [=](int r, int c) { return DN_ALPHA * X2[(size_t)r * 2048 + c] + Y[(size_t)(2 * r) * 2048 + c] + Y[(size_t)(2 * r + 1) * 2048 + c]; },
            p.ln3_g, p.ln3_b, p.out, smem);
}

constexpr int NPHASE = 18;

__global__ void __launch_bounds__(NTHR, 2) naive_kernel(Params p) {
    __shared__ __attribute__((aligned(16))) float smem[8192];
    cg::grid_group grid = cg::this_grid();
    const int lo = p.phase_lo, hi = p.phase_hi;
#define PH(k, body) if (lo <= (k) && (k) < hi) { body; if ((k) + 1 < hi) grid.sync(); }
    PH(0, ph_gemm_xw(p, smem))
    PH(1, ph_act(p))
    PH(2, ph_compress(p, smem); ph_sgu_ln(p, smem))
    PH(3, ph_cmp_attn(p, smem))
    PH(4, ph_nsa_main(p, smem))
    PH(5, ph_sgu_mix(p))
    PH(6, ph_proj_a(p, smem))
    PH(7, ph_proj_b(p, smem))
    PH(8, ph_wo(p, smem))
    PH(9, ph_ln1(p, smem))
    PH(10, ph_xq(p, smem))
    PH(11, ph_xattn(p, smem))
    PH(12, ph_xo(p, smem))
    PH(13, ph_ln2(p, smem))
    PH(14, ph_router(p))
    PH(15, ph_moe_up(p, smem))
    PH(16, ph_moe_down(p, smem))
    PH(17, ph_final(p, smem))
#undef PH
}

#define LAS __attribute__((address_space(3)))
typedef unsigned short bf16_t;
typedef short bf16x8 __attribute__((ext_vector_type(8)));
typedef float f32x4 __attribute__((ext_vector_type(4)));
typedef float f32x2 __attribute__((ext_vector_type(2)));
typedef unsigned u32x4 __attribute__((ext_vector_type(4)));
typedef unsigned u32x2 __attribute__((ext_vector_type(2)));
constexpr int FTHR = 512;
constexpr int BM = 256, BK = 64, HALF = 128, HTB = HALF * BK * 2, STAGE_BYTES = 8 * HTB, NXCD = 8, WGM = 8;
constexpr int LDS_MISC = STAGE_BYTES;
constexpr int LDS_BYTES = STAGE_BYTES + 16384;

__device__ __forceinline__ unsigned cvt_pk_bf16(float lo, float hi) { unsigned r; asm volatile("v_cvt_pk_bf16_f32 %0, %1, %2" : "=v"(r) : "v"(lo), "v"(hi)); return r; }
__device__ __forceinline__ float bf2f(bf16_t v) { return __uint_as_float(((unsigned)v) << 16); }
__device__ __forceinline__ float bflo(unsigned w) { return __uint_as_float(w << 16); }
__device__ __forceinline__ float bfhi(unsigned w) { return __uint_as_float(w & 0xffff0000u); }

__host__ __device__ __forceinline__ int lds_byte(int r, int c) { const int st = (r >> 4) * 2 + (c >> 5), rr = r & 15, cc = c & 31, ob = rr * 64 + cc * 2; return st * 1024 + (ob ^ (((ob >> 9) & 1) << 5)); }
__host__ __device__ __forceinline__ void stage_rc(int b, int& R, int& C) { const int st = b / 1024, sb = b % 1024, swz = sb ^ (((sb >> 9) & 1) << 5); R = (st >> 1) * 16 + swz / 64; C = (st & 1) * 32 + (swz % 64) / 2; }
__host__ __device__ __forceinline__ int perm32(int rho) { const int n = rho >> 4, i = rho & 15; return 8 * (i >> 2) + 4 * n + (i & 3); }

struct Unit { int pm, pn; int e; int mvalid; };

struct StaticOrder {
    int nM, nN, nwg, G, c;
    __device__ void init(int M, int N, int G_, int c_) { nM = M / BM; nN = N / BM; nwg = nM * nN; G = G_; c = c_; }
    __device__ bool next(int i, Unit& u) const {
        const long L = (long)i * G + c; if (L >= nwg) return false;
        int wgid = (int)L; { const int q = nwg / NXCD, r = nwg % NXCD, xcd = wgid % NXCD, off = wgid / NXCD; wgid = (xcd < r ? xcd * (q + 1) : r * (q + 1) + (xcd - r) * q) + off; }
        const int nig = WGM * nN, gid = wgid / nig, fm = gid * WGM, gsz = (nM - fm) < WGM ? (nM - fm) : WGM;
        u.pm = fm + ((wgid % nig) % gsz); u.pn = (wgid % nig) / gsz; u.e = 0; u.mvalid = 256; return true;
    }
};

struct DenseProb {
    const bf16_t* A; const bf16_t* Bt; int lda, ldb;
    static constexpr bool GATHER = false;
    __device__ __forceinline__ const char* a_base(const Unit& u) const { return (const char*)(A + (size_t)u.pm * BM * lda); }
    __device__ __forceinline__ const char* b_base(const Unit& u) const { return (const char*)(Bt + (size_t)u.pn * BM * ldb); }
    __device__ __forceinline__ unsigned a_off(const Unit&, int h, int R, int C) const { return (unsigned)(((h * HALF + R) * lda + C) * 2); }
};

template <class Epi, class Sched, class Prob>
__device__ __forceinline__ void gemm_phase(LAS unsigned char* lds, const Prob P, const int K, const Sched& S, const Epi& E) {
    const int tid = threadIdx.x, wid = __builtin_amdgcn_readfirstlane(tid >> 6), lane = tid & 63, wr = wid >> 2, wc = wid & 3, fr = lane & 15, fq = lane >> 4;
    const int nt = K / BK;
    int sR[2], sC[2];
    unsigned voffB[2];
#pragma unroll
    for (int i = 0; i < 2; ++i) { stage_rc(tid * 16 + i * 8192, sR[i], sC[i]); const int Rb = Epi::PERM ? ((sR[i] & ~31) + perm32(sR[i] & 31)) : sR[i];
        voffB[i] = (unsigned)(Rb * P.ldb + sC[i]) * 2u; }
    const size_t kstep = (size_t)(BK * 2);
    const size_t hstepB = (size_t)HALF * P.ldb * 2;
    const unsigned ldsw = (unsigned)wid * 1024u;
    const int aoff = lds_byte(wr * 64 + fr, fq * 8), boff = lds_byte(wc * 32 + fr, fq * 8);
#define PG8_SA(b, h) (((b) * 2 + (h)) * HTB)
#define PG8_SB(b, h) ((4 + (b) * 2 + (h)) * HTB)
#define PG8_STAGE(bufoff, gbase, voff) do { _Pragma("unroll") for (int _i = 0; _i < 2; ++_i) \
        __builtin_amdgcn_global_load_lds((const unsigned*)((const char*)(gbase) + (voff)[_i]), (LAS unsigned*)(lds + (bufoff) + ldsw + _i * 8192), 16, 0, 0); } while (0)
#define PG8_LDA(dst, b, h) do { _Pragma("unroll") for (int m = 0; m < 4; ++m) _Pragma("unroll") for (int k = 0; k < 2; ++k) dst[m][k] = *(const LAS bf16x8*)(lds + PG8_SA(b, h) + aoff + m * 2048 + k * 1024); } while (0)
#define PG8_LDB(dst, b, h) do { _Pragma("unroll") for (int n = 0; n < 2; ++n) _Pragma("unroll") for (int k = 0; k < 2; ++k) dst[n][k] = *(const LAS bf16x8*)(lds + PG8_SB(b, h) + boff + n * 2048 + k * 1024); } while (0)
#define PG8_MMA(ai, bj, At, Bt) do { __builtin_amdgcn_s_setprio(1); _Pragma("unroll") for (int m = 0; m < 4; ++m) _Pragma("unroll") for (int n = 0; n < 2; ++n) _Pragma("unroll") for (int k = 0; k < 2; ++k) \
        acc[ai][bj][m][n] = __builtin_amdgcn_mfma_f32_16x16x32_bf16(Bt[n][k], At[m][k], acc[ai][bj][m][n], 0, 0, 0); __builtin_amdgcn_s_setprio(0); } while (0)
#define PG8_WAIT_V(n) asm volatile("s_waitcnt vmcnt(" #n ")" ::: "memory")
#define PG8_WAIT_L(n) asm volatile("s_waitcnt lgkmcnt(" #n ")" ::: "memory")
#define PG8_BAR __builtin_amdgcn_s_barrier()
#define PG8_SCHED __builtin_amdgcn_sched_barrier(0)
    Unit cur, nxt; int ui = 0;
    if (!S.next(0, cur)) return;
    f32x4 acc[2][2][4][2];
#pragma unroll
    for (int a = 0; a < 2; ++a)
#pragma unroll
        for (int b = 0; b < 2; ++b)
#pragma unroll
            for (int m = 0; m < 4; ++m)
#pragma unroll
                for (int n = 0; n < 2; ++n) acc[a][b][m][n] = (f32x4){0.f, 0.f, 0.f, 0.f};
    bf16x8 At[4][2], B0[2][2], B1[2][2];
    const char* cA = P.a_base(cur); const char* cB = P.b_base(cur);
    unsigned cOff[2][2], nOff[2][2];
#pragma unroll
    for (int h = 0; h < 2; ++h)
#pragma unroll
        for (int i = 0; i < 2; ++i) cOff[h][i] = P.a_off(cur, h, sR[i], sC[i]);
    PG8_STAGE(PG8_SB(0, 0), cB, voffB); PG8_STAGE(PG8_SA(0, 0), cA, cOff[0]); PG8_STAGE(PG8_SB(0, 1), cB + hstepB, voffB); PG8_STAGE(PG8_SA(0, 1), cA, cOff[1]);
    if (wr == 1) PG8_BAR;
    PG8_WAIT_V(4); PG8_BAR;
    PG8_STAGE(PG8_SB(1, 0), cB + kstep, voffB); PG8_STAGE(PG8_SA(1, 0), cA + kstep, cOff[0]); PG8_STAGE(PG8_SB(1, 1), cB + hstepB + kstep, voffB);
    PG8_WAIT_V(6); PG8_BAR;
    for (;;) {
        const bool has_next = S.next(ui + 1, nxt);
        const char* nA = has_next ? P.a_base(nxt) : cA; const char* nB = has_next ? P.b_base(nxt) : cB;
#pragma unroll
        for (int h = 0; h < 2; ++h)
#pragma unroll
            for (int i = 0; i < 2; ++i) nOff[h][i] = has_next ? P.a_off(nxt, h, sR[i], sC[i]) : cOff[h][i];
        for (int t = 0; t < nt; t += 2) {
            const bool last = (t == nt - 2);
            const char* a1 = cA + (size_t)(t + 1) * kstep;
            const char* a2 = last ? nA : cA + (size_t)(t + 2) * kstep; const char* b2 = last ? nB : cB + (size_t)(t + 2) * kstep;
            const char* a3 = a2 + kstep; const char* b3 = b2 + kstep;
            unsigned o2[2][2];
#pragma unroll
            for (int h = 0; h < 2; ++h)
#pragma unroll
                for (int i = 0; i < 2; ++i) o2[h][i] = last ? nOff[h][i] : cOff[h][i];
            PG8_LDB(B0, 0, 0); PG8_SCHED; PG8_LDA(At, 0, 0); PG8_STAGE(PG8_SA(1, 1), a1, cOff[1]);
            PG8_WAIT_L(8); PG8_BAR; PG8_WAIT_L(0); PG8_MMA(0, 0, At, B0); PG8_BAR; PG8_SCHED;
            PG8_LDB(B1, 0, 1); PG8_STAGE(PG8_SB(0, 0), b2, voffB);
            PG8_BAR; PG8_WAIT_L(0); PG8_MMA(0, 1, At, B1); PG8_BAR;
            PG8_LDA(At, 0, 1); PG8_STAGE(PG8_SA(0, 0), a2, o2[0]);
            PG8_BAR; PG8_WAIT_L(0); PG8_MMA(1, 0, At, B0); PG8_BAR; PG8_SCHED;
            PG8_STAGE(PG8_SB(0, 1), b2 + hstepB, voffB);
            PG8_WAIT_V(6); PG8_BAR; PG8_MMA(1, 1, At, B1); PG8_BAR;
            PG8_LDB(B0, 1, 0); PG8_SCHED; PG8_LDA(At, 1, 0); PG8_STAGE(PG8_SA(0, 1), a2, o2[1]);
            PG8_WAIT_L(8); PG8_BAR; PG8_WAIT_L(0); PG8_MMA(0, 0, At, B0); PG8_BAR; PG8_SCHED;
            PG8_LDB(B1, 1, 1); PG8_STAGE(PG8_SB(1, 0), b3, voffB);
            PG8_BAR; PG8_WAIT_L(0); PG8_MMA(0, 1, At, B1); PG8_BAR;
            PG8_LDA(At, 1, 1); PG8_STAGE(PG8_SA(1, 0), a3, o2[0]);
            PG8_BAR; PG8_WAIT_L(0); PG8_MMA(1, 0, At, B0); PG8_BAR; PG8_SCHED;
            PG8_STAGE(PG8_SB(1, 1), b3 + hstepB, voffB);
            PG8_WAIT_V(6); PG8_BAR; PG8_MMA(1, 1, At, B1); PG8_BAR;
        }
        E(acc, cur, wr, wc, fr, fq);
        if (!has_next) break;
#pragma unroll
        for (int a = 0; a < 2; ++a)
#pragma unroll
            for (int b = 0; b < 2; ++b)
#pragma unroll
                for (int m = 0; m < 4; ++m)
#pragma unroll
                    for (int n = 0; n < 2; ++n) acc[a][b][m][n] = (f32x4){0.f, 0.f, 0.f, 0.f};
        cur = nxt; cA = nA; cB = nB; ++ui;
#pragma unroll
        for (int h = 0; h < 2; ++h)
#pragma unroll
            for (int i = 0; i < 2; ++i) cOff[h][i] = nOff[h][i];
    }
    PG8_WAIT_V(0);
    if (wr == 0) PG8_BAR;
    PG8_BAR;
#undef PG8_SA
#undef PG8_SB
#undef PG8_STAGE
#undef PG8_LDA
#undef PG8_LDB
#undef PG8_MMA
#undef PG8_WAIT_V
#undef PG8_WAIT_L
#undef PG8_BAR
#undef PG8_SCHED
}
constexpr int NPAD = 12032;
struct FParams {
    Params np;
    bf16_t* XB;
    bf16_t* MEMB;
    bf16_t* WIN_T;
    bf16_t* WA_T; bf16_t* WB_T; bf16_t* WO_T;
    bf16_t* WXQ_T;
    bf16_t* WXKV_T;
    bf16_t* WXO_T;
    bf16_t* WGU_T;
    bf16_t* WD_T;
    bf16_t* W1_T;
    bf16_t* W2_T;
    float* ROPE;
    bf16_t* Q;
    bf16_t* KVB;
    float* GATES;
    bf16_t* UVG;
    bf16_t* KXV;
    bf16_t* ONSAB; bf16_t* OSGUB; bf16_t* MERGEDB;
    float* R1; bf16_t* X1B;
    bf16_t* QXB; bf16_t* OXB;
    float* R2; bf16_t* X2B;
    bf16_t* HBB;
    float* YF;
    float* OACC;
    float* STATP;
    bf16_t* WSC;
    float* BIAS1;
    float* PART;
    bf16_t* KCB; bf16_t* VCB;
    bf16_t* MSEL;
    float* IMPACC;
    int dbg; int pad;
};

__device__ __forceinline__ void cvt_rows(const float* __restrict__ src, bf16_t* __restrict__ dst, size_t n8) {
    for (size_t i = (size_t)blockIdx.x * FTHR + threadIdx.x; i < n8; i += (size_t)gridDim.x * FTHR) {
        f32x4 a = ((const f32x4*)src)[2 * i], b = ((const f32x4*)src)[2 * i + 1];
        u32x4 w; w.x = cvt_pk_bf16(a[0], a[1]); w.y = cvt_pk_bf16(a[2], a[3]); w.z = cvt_pk_bf16(b[0], b[1]); w.w = cvt_pk_bf16(b[2], b[3]);
        ((u32x4*)dst)[i] = w;
    }
}
template <class ColPtr>
__device__ __forceinline__ void tconv(int ldsrc, int K, bf16_t* __restrict__ dst, int Nd, ColPtr colptr, float* tile, int& ucursor) {
    const int tid = threadIdx.x;
    const int kts = K / 64, nts = Nd / 64, units = kts * nts;
    int first = (int)(((long)blockIdx.x - ucursor) % (long)gridDim.x); if (first < 0) first += gridDim.x;
    for (int u = first; u < units; u += gridDim.x) {
        const int kt = u % kts, nt = u / kts;
        __syncthreads();
#pragma unroll
        for (int pass = 0; pass < 2; ++pass) {
            const int kk = pass * 32 + (tid >> 4), n4 = tid & 15;
            const float* cp = colptr(nt * 16 + n4);
            f32x4 v = {0.f, 0.f, 0.f, 0.f};
            if (cp) v = *(const f32x4*)(cp + (size_t)(kt * 64 + kk) * ldsrc);
            float* t = tile + kk * 65 + n4 * 4;
            t[0] = v[0]; t[1] = v[1]; t[2] = v[2]; t[3] = v[3];
        }
        __syncthreads();
        {
            const int n = tid >> 3, ks = (tid & 7) * 8;
            float v[8];
#pragma unroll
            for (int j = 0; j < 8; ++j) v[j] = tile[(ks + j) * 65 + n];
            u32x4 w; w.x = cvt_pk_bf16(v[0], v[1]); w.y = cvt_pk_bf16(v[2], v[3]); w.z = cvt_pk_bf16(v[4], v[5]); w.w = cvt_pk_bf16(v[6], v[7]);
            *(u32x4*)(dst + (size_t)(nt * 64 + n) * K + kt * 64 + ks) = w;
        }
    }
    ucursor = (ucursor + units) % (int)gridDim.x;
}

__device__ __forceinline__ int rope_pos2d(int pp) { return 64 * ((pp >> 2) & 1) + 16 * (pp >> 5) + 4 * ((pp >> 3) & 3) + (pp & 3); }

__device__ __forceinline__ void fp0_prologue(const FParams& f, float* tile) {
    const Params& p = f.np;
    const int tid = threadIdx.x;
    if (blockIdx.x == 0 && tid < NEXP) p.CNT[tid] = 0;
    for (int i = blockIdx.x * FTHR + tid; i < SEQ * 64; i += gridDim.x * FTHR) {
        int pos = i >> 6, d = i & 63;
        float c, s; rope_angles(pos, d, c, s);
        f.ROPE[2 * i] = c; f.ROPE[2 * i + 1] = s;
    }
    for (int i = blockIdx.x * FTHR + tid; i < 8 * 128 * 128; i += gridDim.x * FTHR) {
        const int t = (i >> 7) & 127, sx = i & 127;
        f.WSC[i] = (bf16_t)(cvt_pk_bf16(sx <= t ? p.sgu_w_s[i] : 0.f, 0.f) & 0xffffu);
    }
    {
        const int gw = blockIdx.x * (FTHR / 64) + (tid >> 6), lane = tid & 63;
        if (gw < 512) {
            const int kv = gw >> 8, n = gw & 255;
            const float* pe = kv ? p.cmp_pe_v : p.cmp_pe_k; const float* w1 = kv ? p.cmp_w1_v : p.cmp_w1_k;
            float s = 0.f;
            for (int k = lane; k < 4096; k += 64) s = fmaf(pe[k], w1[(size_t)k * 256 + n], s);
#pragma unroll
            for (int o = 32; o > 0; o >>= 1) s += __shfl_xor(s, o);
            if (lane == 0) f.BIAS1[gw] = s;
        }
    }
    for (int i = blockIdx.x * FTHR + tid; i < 256 * 128; i += gridDim.x * FTHR) {
        const int k = i >> 7, j = i & 127;
        float v = 0.f;
        if (j < 64) { const int d = k - 4 * j; v = (d >= 0 && d <= 2) ? 1.0f : ((d == -1 || d == 3) ? 0.5f : 0.f); }
        f.MSEL[i] = (bf16_t)(cvt_pk_bf16(v, 0.f) & 0xffffu);
    }
    for (size_t i = (size_t)blockIdx.x * FTHR + tid; i < (size_t)2 * NTOK * 256 / 4; i += (size_t)gridDim.x * FTHR) ((f32x4*)f.IMPACC)[i] = (f32x4){0.f, 0.f, 0.f, 0.f};
    cvt_rows(p.x, f.XB, (size_t)NTOK * 2048 / 8);
    cvt_rows(p.mem, f.MEMB, (size_t)512 * 2048 / 8);
    int cur = 0;
    {
        const float* w = p.w_in;
        tconv(INW, 2048, f.WIN_T, NPAD, [=](int g) __attribute__((always_inline)) -> const float* {
            int pg = g * 4, pn = pg >> 8, pp = pg & 255;
            if (pn < 14) { int chunk = pn * 2 + (pp >> 7); return w + chunk * 128 + rope_pos2d(pp & 127); }
            if (pn == 14) return pp < 48 ? (w + OFF_G + pp) : nullptr;
            return w + OFF_U + (pn - 15) * 256 + pp;
        }, tile, cur);
    }
    { const float* w = p.w_branch_a; tconv(2048, 2048, f.WA_T, 2048, [=](int g) __attribute__((always_inline)) -> const float* { return w + g * 4; }, tile, cur); }
    { const float* w = p.w_branch_b; tconv(2048, 2048, f.WB_T, 2048, [=](int g) __attribute__((always_inline)) -> const float* { return w + g * 4; }, tile, cur); }
    { const float* w = p.w_o; tconv(2048, 2048, f.WO_T, 2048, [=](int g) __attribute__((always_inline)) -> const float* { return w + g * 4; }, tile, cur); }
    { const float* w = p.w_xq; tconv(512, 2048, f.WXQ_T, 512, [=](int g) __attribute__((always_inline)) -> const float* { return w + g * 4; }, tile, cur); }
    { const float* wk = p.w_xk; const float* wv = p.w_xv;
      tconv(512, 2048, f.WXKV_T, 1024, [=](int g) __attribute__((always_inline)) -> const float* { int c = g * 4; return c < 512 ? (wk + c) : (wv + c - 512); }, tile, cur); }
    { const float* w = p.cmp_w1_k; tconv(256, 4096, f.W1_T, 256, [=](int g) __attribute__((always_inline)) -> const float* { return w + g * 4; }, tile, cur); }
    { const float* w = p.cmp_w1_v; tconv(256, 4096, f.W1_T + (size_t)256 * 4096, 256, [=](int g) __attribute__((always_inline)) -> const float* { return w + g * 4; }, tile, cur); }
    { const float* w = p.w_xo; tconv(2048, 512, f.WXO_T, 2048, [=](int g) __attribute__((always_inline)) -> const float* { return w + g * 4; }, tile, cur); }
}

__device__ __forceinline__ float fast_sigmoid(float x) { return __builtin_amdgcn_rcpf(1.0f + __expf(-x)); }
__device__ __forceinline__ float fast_gelu(float x) {
    const float y = 1.5957691216057308f * (x + 0.044715f * x * x * x);
    return x * __builtin_amdgcn_rcpf(1.0f + __expf(-y));
}
struct EpiXW {
    static constexpr bool PERM = true;
    bf16_t* Q; bf16_t* KVB; float* GATES; bf16_t* UVG; const float* ROPE; float* XWdbg; float* STATP;
    __device__ __forceinline__ void operator()(const f32x4 (&acc)[2][2][4][2], const Unit& u, int wr, int wc, int fr, int fq) const {
        const int pn = u.pn;
        const int row0 = u.pm * BM + wr * 64 + fr;
        if (pn < 14) {
            const int dp = 16 * wc + 4 * fq;
#pragma unroll
            for (int bj = 0; bj < 2; ++bj) {
                const int chunk = pn * 2 + bj;
                const bool rope = (chunk < 16) || chunk == 20 || chunk == 21 || chunk == 24 || chunk == 25;
                const float scale = chunk < 16 ? QSCALE : 1.0f;
#pragma unroll
                for (int ai = 0; ai < 2; ++ai)
#pragma unroll
                    for (int m = 0; m < 4; ++m) {
                        const int r = row0 + ai * HALF + m * 16, pos = r & (SEQ - 1), b = r >> 12;
                        const f32x4 v0 = acc[ai][bj][m][0], v1 = acc[ai][bj][m][1];
                        f32x4 o0 = v0, o1 = v1;
                        if (rope) {
                            const f32x4* rp = (const f32x4*)(ROPE + ((size_t)pos * 64 + dp) * 2);
                            const f32x4 cs0 = rp[0], cs1 = rp[1];
                            o0[0] = v0[0] * cs0[0] - v1[0] * cs0[1]; o1[0] = v0[0] * cs0[1] + v1[0] * cs0[0];
                            o0[1] = v0[1] * cs0[2] - v1[1] * cs0[3]; o1[1] = v0[1] * cs0[3] + v1[1] * cs0[2];
                            o0[2] = v0[2] * cs1[0] - v1[2] * cs1[1]; o1[2] = v0[2] * cs1[1] + v1[2] * cs1[0];
                            o0[3] = v0[3] * cs1[2] - v1[3] * cs1[3]; o1[3] = v0[3] * cs1[3] + v1[3] * cs1[2];
                        }
                        o0 = o0 * scale; o1 = o1 * scale;
                        bf16_t* dst = (chunk < 16) ? (Q + (size_t)r * 2048 + chunk * 128)
                                                   : (KVB + ((size_t)((chunk - 16) * 2 + b) * SEQ + pos) * 128);
                        u32x2 w0, w1; w0.x = cvt_pk_bf16(o0[0], o0[1]); w0.y = cvt_pk_bf16(o0[2], o0[3]); w1.x = cvt_pk_bf16(o1[0], o1[1]); w1.y = cvt_pk_bf16(o1[2], o1[3]);
                        *(u32x2*)(dst + dp) = w0; *(u32x2*)(dst + 64 + dp) = w1;
                        if (XWdbg) {
                            float* xr = XWdbg + (size_t)r * INW + chunk * 128 + dp;
#pragma unroll
                            for (int i = 0; i < 4; ++i) { xr[i] = o0[i]; xr[64 + i] = o1[i]; }
                        }
                    }
            }
        } else if (pn == 14) {
#pragma unroll
            for (int ai = 0; ai < 2; ++ai)
#pragma unroll
                for (int m = 0; m < 4; ++m) {
                    const int r = row0 + ai * HALF + m * 16;
#pragma unroll
                    for (int n = 0; n < 2; ++n) {
                        const int c0 = 32 * wc + 8 * fq + 4 * n;
                        if (c0 < 48) {
                            f32x4 v = acc[ai][0][m][n];
#pragma unroll
                            for (int i = 0; i < 4; ++i) {
                                float s = fast_sigmoid(v[i]);
                                GATES[(size_t)r * 48 + c0 + i] = s;
                                if (XWdbg) XWdbg[(size_t)r * INW + OFF_G + c0 + i] = s;
                            }
                        }
                    }
                }
        } else {
            const int kind = pn < 23 ? 0 : (pn < 31 ? 1 : 2);
            bf16_t* base = UVG + (size_t)kind * ((size_t)NTOK * 2048);
            const int ldc = kind == 2 ? 4096 : 2048;
            const int ctile = (pn - (kind == 0 ? 15 : (kind == 1 ? 23 : 31))) * 256;
#pragma unroll
            for (int ai = 0; ai < 2; ++ai)
#pragma unroll
                for (int m = 0; m < 4; ++m) {
                    const int r = row0 + ai * HALF + m * 16;
                    float ssum = 0.f, ssq = 0.f;
#pragma unroll
                    for (int bj = 0; bj < 2; ++bj) {
                        f32x4 v0 = acc[ai][bj][m][0], v1 = acc[ai][bj][m][1];
                        if (kind == 2) {
#pragma unroll
                            for (int i = 0; i < 4; ++i) { v0[i] = fast_sigmoid(v0[i]); v1[i] = fast_sigmoid(v1[i]); }
                        } else {
#pragma unroll
                            for (int i = 0; i < 4; ++i) { v0[i] = fast_gelu(v0[i]); v1[i] = fast_gelu(v1[i]); }
                        }
                        if (kind == 1) {
#pragma unroll
                            for (int i = 0; i < 4; ++i) { ssum += v0[i] + v1[i]; ssq += v0[i] * v0[i] + v1[i] * v1[i]; }
                        }
                        const int c = ctile + bj * HALF + wc * 32 + 8 * fq;
                        u32x4 w; w.x = cvt_pk_bf16(v0[0], v0[1]); w.y = cvt_pk_bf16(v0[2], v0[3]); w.z = cvt_pk_bf16(v1[0], v1[1]); w.w = cvt_pk_bf16(v1[2], v1[3]);
                        *(u32x4*)(base + (size_t)r * ldc + c) = w;
                        if (XWdbg) {
                            float* xr = XWdbg + (size_t)r * INW + OFF_U + (pn - 15) * 256 + bj * HALF + wc * 32 + 8 * fq;
#pragma unroll
                            for (int i = 0; i < 4; ++i) { xr[i] = v0[i]; xr[4 + i] = v1[i]; }
                        }
                    }
                    if (kind == 1) {
                        ssum += __shfl_xor(ssum, 16); ssum += __shfl_xor(ssum, 32);
                        ssq += __shfl_xor(ssq, 16); ssq += __shfl_xor(ssq, 32);
                        if (fq == 0) { f32x2 st; st.x = ssum; st.y = ssq; *(f32x2*)(STATP + (((size_t)r * 8 + (pn - 23)) * 4 + wc) * 2) = st; }
                    }
                }
        }
    }
};
struct EpiBf16 {
    static constexpr bool PERM = true;
    bf16_t* O; int ldc; float scale;
    __device__ __forceinline__ void operator()(const f32x4 (&acc)[2][2][4][2], const Unit& u, int wr, int wc, int fr, int fq) const {
        const int row0 = u.pm * BM + wr * 64 + fr, col0 = u.pn * BM + wc * 32 + 8 * fq;
#pragma unroll
        for (int ai = 0; ai < 2; ++ai)
#pragma unroll
            for (int m = 0; m < 4; ++m) {
                bf16_t* rowp = O + (size_t)(row0 + ai * HALF + m * 16) * ldc + col0;
#pragma unroll
                for (int bj = 0; bj < 2; ++bj) {
                    f32x4 v0 = acc[ai][bj][m][0] * scale, v1 = acc[ai][bj][m][1] * scale;
                    u32x4 w; w.x = cvt_pk_bf16(v0[0], v0[1]); w.y = cvt_pk_bf16(v0[2], v0[3]); w.z = cvt_pk_bf16(v1[0], v1[1]); w.w = cvt_pk_bf16(v1[2], v1[3]);
                    *(u32x4*)(rowp + bj * HALF) = w;
                }
            }
    }
};

__device__ __forceinline__ void fp1_xw(const FParams& f, LAS unsigned char* lds) {
    {
        DenseProb P{f.XB, f.WIN_T, 2048, 2048};
        StaticOrder S; S.init(NTOK, NPAD, gridDim.x, blockIdx.x);
        EpiXW E{f.Q, f.KVB, f.GATES, f.UVG, f.ROPE, (f.dbg & 1) ? f.np.XW : nullptr, f.STATP};
        gemm_phase(lds, P, 2048, S, E);
    }
    {
        DenseProb P{f.MEMB, f.WXKV_T, 2048, 2048};
        StaticOrder S; S.init(512, 1024, gridDim.x, (int)((blockIdx.x + gridDim.x - 224u) % gridDim.x));
        EpiBf16 E{f.KXV, 1024, 1.0f};
        gemm_phase(lds, P, 2048, S, E);
    }
}

template <class F> struct EpiFn {
    static constexpr bool PERM = true;
    F fn;
    __device__ __forceinline__ void operator()(const f32x4 (&acc)[2][2][4][2], const Unit& u, int wr, int wc, int fr, int fq) const {
#pragma unroll
        for (int ai = 0; ai < 2; ++ai)
#pragma unroll
            for (int m = 0; m < 4; ++m) {
                const int rl = ai * HALF + wr * 64 + m * 16 + fr;
#pragma unroll
                for (int bj = 0; bj < 2; ++bj) fn(u, rl, u.pn * BM + bj * HALF + wc * 32 + 8 * fq, acc[ai][bj][m][0], acc[ai][bj][m][1]);
            }
    }
};
template <class F> __device__ __forceinline__ EpiFn<F> make_epi(F f) { return EpiFn<F>{f}; }
__device__ __forceinline__ u32x4 pack8bf(f32x4 a, f32x4 b) { u32x4 w; w.x = cvt_pk_bf16(a[0], a[1]); w.y = cvt_pk_bf16(a[2], a[3]); w.z = cvt_pk_bf16(b[0], b[1]); w.w = cvt_pk_bf16(b[2], b[3]); return w; }
__device__ __forceinline__ void unpack8bf(u32x4 w, f32x4& a, f32x4& b) { a[0] = bflo(w.x); a[1] = bfhi(w.x); a[2] = bflo(w.y); a[3] = bfhi(w.y); b[0] = bflo(w.z); b[1] = bfhi(w.z); b[2] = bflo(w.w); b[3] = bfhi(w.w); }

__device__ __forceinline__ void cvt_rows_back(const bf16_t* __restrict__ src, int lds_, int c0, float* __restrict__ dst, int rows, int cols) {
    const size_t n8 = (size_t)rows * cols / 8;
    for (size_t i = (size_t)blockIdx.x * FTHR + threadIdx.x; i < n8; i += (size_t)gridDim.x * FTHR) {
        size_t e = i * 8; int r = (int)(e / cols), c = (int)(e % cols);
        u32x4 w = *(const u32x4*)(src + (size_t)r * lds_ + c0 + c);
        f32x4 a, b; unpack8bf(w, a, b);
        *(f32x4*)(dst + e) = a; *(f32x4*)(dst + e + 4) = b;
    }
}

__device__ __forceinline__ void fp5_proj(const FParams& f, LAS unsigned char* lds) {
    const bf16_t* GM = f.UVG + (size_t)2 * NTOK * 2048;
    bf16_t* MB = f.MERGEDB;
    StaticOrder S; S.init(NTOK, 2048, gridDim.x, blockIdx.x);
    {
        DenseProb P{f.ONSAB, f.WA_T, 2048, 2048};
        auto E = make_epi([=](const Unit& u, int rl, int c, f32x4 v0, f32x4 v1) __attribute__((always_inline)) {
            const int r = u.pm * BM + rl;
            f32x4 g0, g1; unpack8bf(*(const u32x4*)(GM + (size_t)r * 4096 + c), g0, g1);
            *(u32x4*)(MB + (size_t)r * 2048 + c) = pack8bf(v0 * g0, v1 * g1);
        });
        gemm_phase(lds, P, 2048, S, E);
    }
    {
        DenseProb P{f.OSGUB, f.WB_T, 2048, 2048};
        auto E = make_epi([=](const Unit& u, int rl, int c, f32x4 v0, f32x4 v1) __attribute__((always_inline)) {
            const int r = u.pm * BM + rl;
            f32x4 g0, g1; unpack8bf(*(const u32x4*)(GM + (size_t)r * 4096 + 2048 + c), g0, g1);
            f32x4 m0, m1; unpack8bf(*(const u32x4*)(MB + (size_t)r * 2048 + c), m0, m1);
            *(u32x4*)(MB + (size_t)r * 2048 + c) = pack8bf(m0 + v0 * g0, m1 + v1 * g1);
        });
        gemm_phase(lds, P, 2048, S, E);
    }
}
__device__ __forceinline__ void fp6_wo(const FParams& f, LAS unsigned char* lds) {
    const float* x = f.np.x; float* R1 = f.R1;
    StaticOrder S; S.init(NTOK, 2048, gridDim.x, blockIdx.x);
    DenseProb P{f.MERGEDB, f.WO_T, 2048, 2048};
    auto E = make_epi([=](const Unit& u, int rl, int c, f32x4 v0, f32x4 v1) __attribute__((always_inline)) {
        const size_t o = (size_t)(u.pm * BM + rl) * 2048 + c;
        const f32x4 x0 = *(const f32x4*)(x + o), x1 = *(const f32x4*)(x + o + 4);
        *(f32x4*)(R1 + o) = x0 * DN_ALPHA + v0; *(f32x4*)(R1 + o + 4) = x1 * DN_ALPHA + v1;
    });
    gemm_phase(lds, P, 2048, S, E);
}
__device__ __forceinline__ void fp8_xq(const FParams& f, LAS unsigned char* lds) {
    bf16_t* QXB = f.QXB; float* QXdbg = (f.dbg & 8) ? f.np.QX : nullptr;
    StaticOrder S; S.init(NTOK, 512, gridDim.x, blockIdx.x);
    DenseProb P{f.X1B, f.WXQ_T, 2048, 2048};
    auto E = make_epi([=](const Unit& u, int rl, int c, f32x4 v0, f32x4 v1) __attribute__((always_inline)) {
        const size_t o = (size_t)(u.pm * BM + rl) * 512 + c;
        v0 = v0 * QSCALE; v1 = v1 * QSCALE;
        *(u32x4*)(QXB + o) = pack8bf(v0, v1);
        if (QXdbg) { *(f32x4*)(QXdbg + o) = v0; *(f32x4*)(QXdbg + o + 4) = v1; }
    });
    gemm_phase(lds, P, 2048, S, E);
}
__device__ __forceinline__ void fp10_xo(const FParams& f, LAS unsigned char* lds) {
    const float* X1 = f.R1; float* R2 = f.R2;
    StaticOrder S; S.init(NTOK, 2048, gridDim.x, blockIdx.x);
    DenseProb P{f.OXB, f.WXO_T, 512, 512};
    auto E = make_epi([=](const Unit& u, int rl, int c, f32x4 v0, f32x4 v1) __attribute__((always_inline)) {
        const size_t o = (size_t)(u.pm * BM + rl) * 2048 + c;
        const f32x4 x0 = *(const f32x4*)(X1 + o), x1 = *(const f32x4*)(X1 + o + 4);
        *(f32x4*)(R2 + o) = x0 * DN_ALPHA + v0; *(f32x4*)(R2 + o + 4) = x1 * DN_ALPHA + v1;
    });
    gemm_phase(lds, P, 512, S, E);
}

struct MoeOrder {
    const int* cnt; int NT; int G; int c;
    __device__ bool next(int i, Unit& u) const {
        int L = i * G + c;
        for (int e = 0; e < NEXP; ++e) {
            const int n = cnt[e]; const int units = ((n + 255) >> 8) * NT;
            if (L < units) { u.e = e; u.pm = L / NT; u.pn = L % NT; u.mvalid = min(256, n - u.pm * 256); return true; }
            L -= units;
        }
        return false;
    }
};
struct MoeProb {
    const bf16_t* A; const bf16_t* Bt; const int* list; int lda, ldb; int shift; size_t bstride;
    __device__ __forceinline__ const char* a_base(const Unit&) const { return (const char*)A; }
    __device__ __forceinline__ const char* b_base(const Unit& u) const { return (const char*)(Bt + (size_t)u.e * bstride + (size_t)u.pn * BM * ldb); }
    __device__ __forceinline__ unsigned a_off(const Unit& u, int h, int R, int C) const {
        const int rl = h * HALF + R;
        const int idx = list[u.e * LISTCAP + u.pm * 256 + (rl < u.mvalid ? rl : 0)] >> shift;
        return (unsigned)((idx * lda + C) * 2);
    }
};
__device__ __forceinline__ void fp12_moe_up(const FParams& f, LAS unsigned char* lds) {
    const int* list = f.np.LIST; bf16_t* HBB = f.HBB;
    MoeOrder S{f.np.CNT, 4, (int)gridDim.x, (int)blockIdx.x};
    MoeProb P{f.X2B, f.WGU_T, list, 2048, 2048, 1, (size_t)1024 * 2048};
    auto E = make_epi([=](const Unit& u, int rl, int c, f32x4 g, f32x4 up) __attribute__((always_inline)) {
        if (rl < u.mvalid) {
            const int a = list[u.e * LISTCAP + u.pm * 256 + rl];
            f32x4 h;
#pragma unroll
            for (int i = 0; i < 4; ++i) h[i] = g[i] * fast_sigmoid(g[i]) * up[i];
            u32x2 w; w.x = cvt_pk_bf16(h[0], h[1]); w.y = cvt_pk_bf16(h[2], h[3]);
            *(u32x2*)(HBB + (size_t)a * EFF + (c >> 1)) = w;
        }
    });
    gemm_phase(lds, P, 2048, S, E);
}
__device__ __forceinline__ void fp13_moe_down(const FParams& f, LAS unsigned char* lds) {
    const int* list = f.np.LIST; float* Y = f.YF; const float* WGT = f.np.WGT;
    MoeOrder S{f.np.CNT, 8, (int)gridDim.x, (int)blockIdx.x};
    MoeProb P{f.HBB, f.WD_T, list, EFF, EFF, 0, (size_t)2048 * EFF};
    auto E = make_epi([=](const Unit& u, int rl, int c, f32x4 v0, f32x4 v1) __attribute__((always_inline)) {
        if (rl < u.mvalid) {
            const int a = list[u.e * LISTCAP + u.pm * 256 + rl];
            const float w = WGT[a];
            float* y = Y + (size_t)a * 2048 + c;
            *(f32x4*)y = v0 * w; *(f32x4*)(y + 4) = v1 * w;
        }
    });
    gemm_phase(lds, P, EFF, S, E);
}
__device__ __forceinline__ void fp_conv_experts(const FParams& f, float* tile) {
    int cur = 0;
    for (int e = 0; e < NEXP; ++e) {
        const float* wg = f.np.w_exp_gate + (size_t)e * 2048 * EFF; const float* wu = f.np.w_exp_up + (size_t)e * 2048 * EFF;
        tconv(EFF, 2048, f.WGU_T + (size_t)e * 1024 * 2048, 1024, [=](int g) __attribute__((always_inline)) -> const float* {
            const int p = g * 4; const int c = ((p >> 3) << 2);
            return ((p >> 2) & 1) ? (wu + c) : (wg + c);
        }, tile, cur);
        const float* wd = f.np.w_exp_down + (size_t)e * EFF * 2048;
        tconv(2048, EFF, f.WD_T + (size_t)e * 2048 * EFF, 2048, [=](int g) __attribute__((always_inline)) -> const float* { return wd + g * 4; }, tile, cur);
    }
}
namespace att {
constexpr int NW = 8, QBLK = 32, KVBLK = 64, QB = NW * QBLK, D = 128;
constexpr int SHM_V = KVBLK * D * 2, SHM_K = KVBLK * D * 2;
constexpr int WS_OFF = 2 * SHM_V + 2 * SHM_K;
constexpr int MSK_OFF = WS_OFF + NW * 64 * 4;
constexpr int ATT_LDS = MSK_OFF + QB * 8;
constexpr float THR = 8.f;
constexpr float SCALE = 1.0f;
typedef short s16x4 __attribute__((ext_vector_type(4)));
typedef float f32x16 __attribute__((ext_vector_type(16)));

#define KSWZ(row, colB) ((row) * 256 + ((colB) ^ (((row) & 7) << 4)))
#define SBAR() __builtin_amdgcn_sched_barrier(0)
__device__ __forceinline__ int v_st(int k, int c) { const int kk = (k & ~0xC) | ((k & 4) << 1) | ((k & 8) >> 1); return ((kk >> 3) * 4 + (c >> 5)) * 512 + ((kk & 7) * 32 + (c & 31)) * 2; }
__device__ __forceinline__ int v_rd_base(int lane) { return ((lane & 3) << 3) | (((lane >> 2) & 3) << 6) | (((lane >> 4) & 1) << 5) | (((lane >> 5) & 1) << 8); }
constexpr int v_rd_off(int d0, int ks, int half) { return d0 * 512 + ks * 4096 + half * 2048; }
__device__ __forceinline__ int crow(int r, int hi) { return (r & 3) + 8 * (r >> 2) + 4 * hi; }
__device__ __forceinline__ unsigned cvtpk(float lo, float hi) { unsigned r; asm volatile("v_cvt_pk_bf16_f32 %0, %1, %2" : "=v"(r) : "v"(lo), "v"(hi)); return r; }
__device__ __forceinline__ bf16x8 load8(const bf16_t* p) { return *reinterpret_cast<const bf16x8*>(p); }

__device__ __forceinline__ void mask_tile(f32x16& p0, f32x16& p1, int dq, unsigned W) {
    const float NEG = -__builtin_inff();
#pragma unroll
    for (int r = 0; r < 16; ++r) {
        const int c = (r & 3) + 8 * (r >> 2);
        if ((unsigned)(dq - c) >= W) p0[r] = NEG;
        if ((unsigned)(dq - c - 32) >= W) p1[r] = NEG;
    }
}
__device__ __forceinline__ void kill_tile(f32x16& p0, f32x16& p1, bool keep) {
    const float NEG = -__builtin_inff();
#pragma unroll
    for (int r = 0; r < 16; ++r) { p0[r] = keep ? p0[r] : NEG; p1[r] = keep ? p1[r] : NEG; }
}
__device__ __forceinline__ void partialSM(f32x16& p0, f32x16& p1, float& m_reg, float& mn, float& alpha) {
    float pmax = p0[0];
#pragma unroll
    for (int r = 1; r < 16; ++r) pmax = fmaxf(pmax, p0[r]);
#pragma unroll
    for (int r = 0; r < 16; ++r) pmax = fmaxf(pmax, p1[r]);
    { auto rr = __builtin_amdgcn_permlane32_swap(__float_as_uint(pmax), __float_as_uint(pmax), false, false);
      pmax = fmaxf(__uint_as_float(rr[0]), __uint_as_float(rr[1])); }
    constexpr float C2 = 1.4426950408889634f * SCALE;
    if (__builtin_expect(__all((pmax - m_reg) * SCALE <= THR), 1)) { mn = m_reg; alpha = 1.f; }
    else { mn = fmaxf(m_reg, pmax); alpha = __builtin_amdgcn_exp2f((m_reg - mn) * C2); m_reg = mn; }
    const float mnL = -mn * C2;
#pragma unroll
    for (int r = 0; r < 16; ++r) p0[r] = fmaf(p0[r], C2, mnL);
#pragma unroll
    for (int r = 0; r < 16; ++r) p1[r] = fmaf(p1[r], C2, mnL);
#pragma unroll
    for (int r = 0; r < 16; ++r) p0[r] = __builtin_amdgcn_exp2f(p0[r]);
}
__device__ __forceinline__ void finishSM(f32x16& p0, f32x16& p1, float alpha, float& l_reg, bf16x8& pa0, bf16x8& pa1, bf16x8& pa2, bf16x8& pa3) {
#pragma unroll
    for (int r = 0; r < 16; ++r) p1[r] = __builtin_amdgcn_exp2f(p1[r]);
    float ps = 0;
#pragma unroll
    for (int r = 0; r < 16; ++r) ps += p0[r];
#pragma unroll
    for (int r = 0; r < 16; ++r) ps += p1[r];
    { auto rr = __builtin_amdgcn_permlane32_swap(__float_as_uint(ps), __float_as_uint(ps), false, false);
      ps = __uint_as_float(rr[0]) + __uint_as_float(rr[1]); }
    l_reg = l_reg * alpha + ps;
#define PK4(P, B_, OUT) do { unsigned a0 = cvtpk(P[B_+0], P[B_+1]), a1 = cvtpk(P[B_+2], P[B_+3]);                          \
        unsigned b0 = cvtpk(P[B_+4], P[B_+5]), b1 = cvtpk(P[B_+6], P[B_+7]);                                             \
        auto r0 = __builtin_amdgcn_permlane32_swap(a0, b0, false, false); auto r1 = __builtin_amdgcn_permlane32_swap(a1, b1, false, false); \
        u32x4 w = {r0[0], r1[0], r0[1], r1[1]}; OUT = *reinterpret_cast<bf16x8*>(&w); } while (0)
    PK4(p0, 0, pa0); PK4(p0, 8, pa1); PK4(p1, 0, pa2); PK4(p1, 8, pa3);
#undef PK4
}
template <int KB, bool SK>
__device__ __forceinline__ void qkt(f32x16& p0, f32x16& p1, const char* K_lds, int r32, int hi, const bf16x8* qr, bool act) {
    if (SK && !act) { const float NEG = -__builtin_inff();
#pragma unroll
        for (int r = 0; r < 16; ++r) { p0[r] = NEG; p1[r] = NEG; } return; }
    p0 = f32x16{}; p1 = f32x16{};
    const char* kb[4];
#pragma unroll
    for (int dd = 0; dd < 4; ++dd) kb[dd] = K_lds + KB * SHM_K + KSWZ(r32, (dd * 16 + hi * 8) * 2);
#pragma unroll
    for (int d0 = 0; d0 < 8; ++d0) { const char* a = kb[d0 & 3] + (d0 >> 2) * 128;
        bf16x8 b0 = *reinterpret_cast<const bf16x8*>(a);
        bf16x8 b1 = *reinterpret_cast<const bf16x8*>(a + 32 * 256);
        p0 = __builtin_amdgcn_mfma_f32_32x32x16_bf16(b0, qr[d0], p0, 0, 0, 0);
        p1 = __builtin_amdgcn_mfma_f32_32x32x16_bf16(b1, qr[d0], p1, 0, 0, 0); }
}
template <int VB, bool SK>
__device__ __forceinline__ void pv_tile(f32x16* o, int vb0, bf16x8 pa0, bf16x8 pa1, bf16x8 pa2, bf16x8 pa3, bool act) {
    if (SK && !act) return;
#define TRRD(dst, off) asm volatile("ds_read_b64_tr_b16 %0, %1 offset:%2" : "=&v"(dst) : "v"(vb0), "i"(off) : "memory")
#define PV_D0(d0) do { s16x4 l0, l1, l2, l3, h0, h1, h2, h3; constexpr int b_ = VB * SHM_V + v_rd_off(d0, 0, 0); \
        TRRD(l0, b_); TRRD(h0, b_ + 2048); TRRD(l1, b_ + 4096); TRRD(h1, b_ + 6144); TRRD(l2, b_ + 8192); TRRD(h2, b_ + 10240); TRRD(l3, b_ + 12288); TRRD(h3, b_ + 14336); \
        asm volatile("s_waitcnt lgkmcnt(0)" ::: "memory"); SBAR();   \
        o[d0] = __builtin_amdgcn_mfma_f32_32x32x16_bf16(pa0, (bf16x8){l0[0], l0[1], l0[2], l0[3], h0[0], h0[1], h0[2], h0[3]}, o[d0], 0, 0, 0);   \
        o[d0] = __builtin_amdgcn_mfma_f32_32x32x16_bf16(pa1, (bf16x8){l1[0], l1[1], l1[2], l1[3], h1[0], h1[1], h1[2], h1[3]}, o[d0], 0, 0, 0);   \
        o[d0] = __builtin_amdgcn_mfma_f32_32x32x16_bf16(pa2, (bf16x8){l2[0], l2[1], l2[2], l2[3], h2[0], h2[1], h2[2], h2[3]}, o[d0], 0, 0, 0);   \
        o[d0] = __builtin_amdgcn_mfma_f32_32x32x16_bf16(pa3, (bf16x8){l3[0], l3[1], l3[2], l3[3], h3[0], h3[1], h3[2], h3[3]}, o[d0], 0, 0, 0); } while (0)
    PV_D0(0); PV_D0(1); PV_D0(2); PV_D0(3);
#undef PV_D0
#undef TRRD
}

struct BlockRef { const bf16_t* Q; const bf16_t* K; const bf16_t* V; int P0; float* OACC; bf16_t* OUTB; const float* gate; const unsigned long long* rowmask; };
template <int LDQ, int LDKV, int LDO, int LDG, int MSTR> struct Geo { static constexpr int ldq = LDQ, ldkv = LDKV, ldo = LDO, ldg = LDG, maskstride = MSTR; };
struct Seam { bf16x8 qr[8]; bf16x8 st_v0, st_v1, st_k0, st_k1; };
__device__ __forceinline__ int swa_jlo(int P0, int W) { const int lowk = P0 - W + 1; return lowk > 0 ? lowk / KVBLK : 0; }
#define VMW() asm volatile("s_waitcnt vmcnt(0)" ::: "memory")
#define VMWN(n) asm volatile("s_waitcnt vmcnt(%0)" :: "i"(n) : "memory")
#define SLOAD_H(Kp, Vp, k0) do { const bf16_t* vb_ = (Vp) + (size_t)(k0) * G.ldkv; const bf16_t* kb2_ = (Kp) + (size_t)(k0) * G.ldkv;          \
                         S.st_v0 = load8(vb_ + toff); S.st_v1 = load8(vb_ + toff + 32 * G.ldkv);              \
                         S.st_k0 = load8(kb2_ + toff); S.st_k1 = load8(kb2_ + toff + 32 * G.ldkv); } while (0)
#define SWRITE_HK(bf) do { *(bf16x8*)(K_lds + (bf) * SHM_K + kws) = S.st_k0; *(bf16x8*)(K_lds + (bf) * SHM_K + kws + 32 * 256) = S.st_k1; } while (0)
#define SWRITE_HV(bf) do { *(bf16x8*)(V_lds + (bf) * SHM_V + vst0) = S.st_v0; *(bf16x8*)(V_lds + (bf) * SHM_V + vst1) = S.st_v1; } while (0)
#define SWRITE_H(bf) do { SWRITE_HV(bf); SWRITE_HK(bf); } while (0)

template <bool SELM, class GEO>
__device__ __forceinline__ void attn_prime(const BlockRef& cur, int W, char* lds, Seam& S) {
    constexpr GEO G{};
    const int tid = threadIdx.x, wid = __builtin_amdgcn_readfirstlane(tid >> 6), lane = tid & 63, r32 = lane & 31, hi = lane >> 5;
    const int sr = tid >> 4, sc = (tid & 15) * 8, kws = KSWZ(sr, sc * 2); char* K_lds = lds + 2 * SHM_V;
    const unsigned toff = (unsigned)(sr * G.ldkv + sc), qoff = (unsigned)((wid * QBLK + r32) * G.ldq + hi * 8);
    const int kb0 = swa_jlo(cur.P0, W) * KVBLK;
#pragma unroll
    for (int d0 = 0; d0 < 8; ++d0) S.qr[d0] = load8(cur.Q + qoff + d0 * 16);
    if (SELM) { if (lane < 32) ((unsigned long long*)(lds + MSK_OFF))[wid * 32 + lane] = cur.rowmask[(unsigned)((wid * 32 + lane) * G.maskstride)]; }
    SLOAD_H(cur.K, cur.V, kb0); VMW(); SWRITE_HK(0);
    __syncthreads();
}
template <int MODE, bool SK, bool SELM, class GEO, bool CMPM = false>
__device__ __forceinline__ void attn_block(const BlockRef& cur, const BlockRef& nxt, int skv, int W, char* lds, Seam& S) {
    constexpr GEO G{};
    const int tid = threadIdx.x, wid = __builtin_amdgcn_readfirstlane(tid >> 6), lane = tid & 63, r32 = lane & 31, hi = lane >> 5;
    const int j_lo = swa_jlo(cur.P0, W);
    int j_hi = CMPM ? ((((cur.P0 + QB - 1 - 31) >> 4) >> 6) + 1) : ((cur.P0 + QB - 1) / KVBLK + 1); if (j_hi > skv / KVBLK) j_hi = skv / KVBLK;
    const int NT = j_hi - j_lo;
    const int kbn = swa_jlo(nxt.P0, W) * KVBLK;
    const int qlo = cur.P0 + wid * QBLK, qm = CMPM ? (((qlo + r32 - 31) >> 4) - 4 * hi) : (qlo + r32 - 4 * hi);
    char* V_lds = lds; char* K_lds = lds + 2 * SHM_V;
    float* ws = (float*)(lds + WS_OFF) + wid * 64; float* li_l = ws, * al_l = ws + 32;
    const unsigned long long* msk_l = (const unsigned long long*)(lds + MSK_OFF) + wid * 32;
    float m_reg = -1e30f, l_reg = 0; f32x16 o[4] = {};
    const int sr = tid >> 4, sc = (tid & 15) * 8, vst0 = v_st(sr, sc), vst1 = v_st(32 + sr, sc), kws = KSWZ(sr, sc * 2);
    const unsigned toff = (unsigned)(sr * G.ldkv + sc), qoff = (unsigned)((wid * QBLK + r32) * G.ldq + hi * 8);
    const int vb0 = (int)(uintptr_t)V_lds + v_rd_base(lane);
    const bf16_t* Kh = cur.K; const bf16_t* Vh = cur.V;
#define RESC(a) do { if (__any((a) < 1.f)) { if (hi == 0) al_l[r32] = (a); asm volatile("s_waitcnt lgkmcnt(0)" ::: "memory");              \
                     for (int d_ = 0; d_ < 4; ++d_) for (int r = 0; r < 16; ++r) o[d_][r] *= al_l[crow(r, hi)]; } } while (0)
#define KBASE(t) ((j_lo + (t)) * KVBLK)
#define ACT(t) (KBASE(t) <= qlo + QBLK - 1 && KBASE(t) + KVBLK - 1 >= qlo - W + 1)
#define MASKT(P0_, P1_, t) do { const int kb_ = KBASE(t); if (CMPM || ((!SK || ACT(t)) && (kb_ + KVBLK - 1 > qlo || kb_ <= qlo + QBLK - 1 - W))) mask_tile(P0_, P1_, qm - kb_, (unsigned)W); \
        if (SELM) { const unsigned long long mk_ = msk_l[r32]; kill_tile(P0_, P1_, ((mk_ >> (j_lo + (t))) & 1ull) != 0ull); } } while (0)
    constexpr int NQL = 8;
#define SEAM_K0() do { VMWN(NQL); SWRITE_HK(0); SBAR(); } while (0)
    f32x16 pA0, pA1, pB0, pB1; float mnA, mnB, alA, alB; bf16x8 pa0, pa1, pa2, pa3;
    SWRITE_HV(0); SBAR();
    if (NT > 1) { SLOAD_H(Kh, Vh, KBASE(1)); }
    SBAR(); qkt<0, SK>(pA0, pA1, K_lds, r32, hi, S.qr, ACT(0));
    MASKT(pA0, pA1, 0); partialSM(pA0, pA1, m_reg, mnA, alA);
    if (NT > 1) { VMW(); SWRITE_H(1); }
    __syncthreads();
#define HALF_STEP(PX0, PX1, mnX, alX, PY0, PY1, alY, t, KB, VB, SB) do {                                                      \
        SBAR(); qkt<KB, SK>(PX0, PX1, K_lds, r32, hi, S.qr, ACT(t));                                             \
        finishSM(PY0, PY1, alY, l_reg, pa0, pa1, pa2, pa3); SBAR();                                                           \
        if ((t) + 1 < NT) { SLOAD_H(Kh, Vh, KBASE((t) + 1)); SBAR(); }                                               \
        pv_tile<VB, SK>(o, vb0, pa0, pa1, pa2, pa3, ACT((t) - 1)); MASKT(PX0, PX1, (t)); partialSM(PX0, PX1, m_reg, mnX, alX);                                        \
        __syncthreads();                                                                                                      \
        if ((t) + 1 < NT) { VMW(); SWRITE_H(SB); }                                                                          \
        RESC(alX); __syncthreads(); } while (0)
    for (int t = 1; t + 1 < NT; t += 2) {
        HALF_STEP(pB0, pB1, mnB, alB, pA0, pA1, alA, t, 1, 0, 0);
        HALF_STEP(pA0, pA1, mnA, alA, pB0, pB1, alB, t + 1, 0, 1, 1);
    }
    const bool even = (NT & 1) == 0;
    if (even) { SBAR(); qkt<1, SK>(pB0, pB1, K_lds, r32, hi, S.qr, ACT(NT - 1)); SBAR(); }
    SLOAD_H(nxt.K, nxt.V, kbn); SBAR();
#pragma unroll
    for (int d0 = 0; d0 < 8; ++d0) S.qr[d0] = load8(nxt.Q + qoff + d0 * 16);
    SBAR();
    finishSM(pA0, pA1, alA, l_reg, pa0, pa1, pa2, pa3); SBAR();
    pv_tile<0, SK>(o, vb0, pa0, pa1, pa2, pa3, ACT(even ? NT - 2 : NT - 1));
    if (even) { MASKT(pB0, pB1, NT - 1); partialSM(pB0, pB1, m_reg, mnB, alB); __syncthreads(); RESC(alB);
        finishSM(pB0, pB1, alB, l_reg, pa0, pa1, pa2, pa3); SBAR(); pv_tile<1, SK>(o, vb0, pa0, pa1, pa2, pa3, ACT(NT - 1)); }
    SBAR(); SEAM_K0();
    if (hi == 0) { li_l[r32] = l_reg; al_l[r32] = cur.gate ? cur.gate[(unsigned)((wid * QBLK + r32) * G.ldg)] : 1.0f; }
    if (SELM) { if (lane < 32) ((unsigned long long*)(lds + MSK_OFF))[wid * 32 + lane] = nxt.rowmask[(unsigned)((wid * 32 + lane) * G.maskstride)]; }
    asm volatile("s_waitcnt lgkmcnt(0)" ::: "memory");
    float rli[16];
#pragma unroll
    for (int r = 0; r < 16; ++r) { const float l_ = li_l[crow(r, hi)]; rli[r] = l_ > 0.f ? al_l[crow(r, hi)] * __builtin_amdgcn_rcpf(l_) : 0.f; }
#pragma unroll
    for (int rg = 0; rg < 4; ++rg) {
        float prev[4][4];
        if (MODE == 0 || MODE == 1) {
#pragma unroll
            for (int rr = 0; rr < 4; ++rr)
#pragma unroll
                for (int d0 = 0; d0 < 4; ++d0) prev[rr][d0] = cur.OACC[(unsigned)((wid * QBLK + crow(rg * 4 + rr, hi)) * G.ldo + d0 * 32 + r32)];
        }
#pragma unroll
        for (int rr = 0; rr < 4; ++rr) { const int r = rg * 4 + rr; const int orow = wid * QBLK + crow(r, hi);
#pragma unroll
            for (int d0 = 0; d0 < 4; ++d0) { float v = o[d0][r] * rli[r];
                const unsigned off = (unsigned)(orow * G.ldo + d0 * 32 + r32);
                if (MODE == 0 || MODE == 1) v += prev[rr][d0];
                if (MODE == 0 || MODE == 3) { cur.OACC[off] = v; }
                else { const float vn = __shfl_xor(v, 1);
                       if ((r32 & 1) == 0) *(unsigned*)(cur.OUTB + off) = cvtpk(v, vn); } } }
        asm volatile("" ::: "memory");
    }
    __syncthreads();
#undef RESC
#undef KBASE
#undef ACT
#undef MASKT
#undef SEAM_K0
#undef HALF_STEP
}
#undef VMW
#undef VMWN
#undef SLOAD_H
#undef SWRITE_HK
#undef SWRITE_HV
#undef SWRITE_H
#undef KSWZ
#undef SBAR
}
template <class T> __device__ __forceinline__ T* uni_ptr(T* p) {
    unsigned long long v = (unsigned long long)p;
    unsigned lo = __builtin_amdgcn_readfirstlane((unsigned)v), hi = __builtin_amdgcn_readfirstlane((unsigned)(v >> 32));
    return (T*)(((unsigned long long)hi << 32) | lo);
}
__device__ __forceinline__ att::BlockRef uni_ref(att::BlockRef r) {
    r.Q = uni_ptr(r.Q); r.K = uni_ptr(r.K); r.V = uni_ptr(r.V); r.P0 = __builtin_amdgcn_readfirstlane(r.P0);
    r.OACC = uni_ptr(r.OACC); r.OUTB = uni_ptr(r.OUTB); r.gate = uni_ptr(r.gate); r.rowmask = uni_ptr(r.rowmask);
    return r;
}
template <int MODE, bool SK, bool SELM, class GEO, bool CMPM = false, class RefFn>
__device__ __forceinline__ void attn_stream(int nblk, RefFn ref, int skv, int W, char* lds) {
    att::BlockRef cur = uni_ref(ref(0));
    att::Seam S;
    att::attn_prime<SELM, GEO>(cur, W, lds, S);
    for (int i = 0; i < nblk; ++i) {
        const att::BlockRef nxt = uni_ref(ref((i + 1 < nblk) ? i + 1 : i));
        att::attn_block<MODE, SK, SELM, GEO, CMPM>(cur, nxt, skv, W, lds, S);
        cur = nxt;
    }
}
__device__ __forceinline__ void fp4_attn(const FParams& f, char* lds) {
    using GEO = att::Geo<2048, 128, 2048, 48, 2>;
    for (int it = blockIdx.x; it < BATCH * NH * 8; it += gridDim.x) {
        const int b = it / (NH * 8), h = (it >> 3) & (NH - 1), pr = it & 7, g = h >> 3;
        const bf16_t* Q = f.Q; float* OACC = f.OACC; bf16_t* ONSAB = f.ONSAB; const unsigned long long* SM = f.np.SELMASK; const bf16_t* KVB = f.KVB; const float* GATES = f.GATES;
        auto mkref = [=](int i, int kch, int vch, int gi) __attribute__((always_inline)) {
            const int qb = i ? 15 - pr : pr;
            const int tok0 = b * SEQ + qb * 256;
            att::BlockRef r;
            r.Q = Q + (size_t)tok0 * 2048 + h * 128; r.P0 = qb * 256;
            r.OACC = OACC + (size_t)tok0 * 2048 + h * 128; r.OUTB = ONSAB + (size_t)tok0 * 2048 + h * 128;
            r.rowmask = SM + (size_t)tok0 * 2 + g;
            r.K = KVB + (size_t)((kch + g) * 2 + b) * SEQ * 128; r.V = KVB + (size_t)((vch + g) * 2 + b) * SEQ * 128; r.gate = GATES + (size_t)tok0 * 48 + h * 3 + gi;
            return r;
        };
        attn_stream<0, true, false, GEO>(2, [=](int i) __attribute__((always_inline)) { return mkref(i, 8, 10, 2); }, SEQ, 512, lds);
        attn_stream<1, false, true, GEO>(2, [=](int i) __attribute__((always_inline)) { return mkref(i, 4, 6, 1); }, SEQ, 1 << 28, lds);
    }
}
__device__ __forceinline__ void fp9_xattn(const FParams& f, char* lds) {
    using GEO = att::Geo<512, 1024, 512, 0, 0>;
    for (int it = blockIdx.x; it < (NTOK / 256) * 4; it += gridDim.x) {
        const int tb = it >> 2, h = it & 3, b = tb / (SEQ / 256);
        const bf16_t* QXB = f.QXB; const bf16_t* KXV = f.KXV; bf16_t* OXB = f.OXB;
        attn_stream<2, false, false, GEO>(1, [=](int) __attribute__((always_inline)) {
            att::BlockRef r;
            r.Q = QXB + (size_t)tb * 256 * 512 + h * 128; r.P0 = 256;
            r.K = KXV + (size_t)b * MEM_LEN * 1024 + h * 128; r.V = r.K + 512;
            r.OACC = nullptr; r.OUTB = OXB + (size_t)tb * 256 * 512 + h * 128; r.gate = nullptr; r.rowmask = nullptr;
            return r; }, MEM_LEN, 1 << 28, lds);
    }
}
__device__ __forceinline__ void dbg_oacc(const FParams& f) {
    const size_t n = (size_t)NTOK * 2048;
    for (size_t i = (size_t)blockIdx.x * FTHR + threadIdx.x; i < n; i += (size_t)gridDim.x * FTHR) {
        const int tok = (int)(i >> 11), h = (int)((i >> 7) & 15);
        f.OACC[i] = f.GATES[(size_t)tok * 48 + h * 3] * f.np.OC[i];
    }
}
__device__ __forceinline__ float wsum(float v) {
#pragma unroll
    for (int o = 32; o > 0; o >>= 1) v += __shfl_xor(v, o);
    return v;
}
template <class Load>
__device__ __forceinline__ void ln_row(Load load, int row, const float* __restrict__ g, const float* __restrict__ bta, f32x4 (&v)[8]) {
    const int lane = threadIdx.x & 63;
    float s = 0.f;
#pragma unroll
    for (int i = 0; i < 8; ++i) { v[i] = load(row, 4 * (lane + 64 * i)); s += v[i][0] + v[i][1] + v[i][2] + v[i][3]; }
    const float mu = wsum(s) * (1.0f / 2048.0f);
    float q = 0.f;
#pragma unroll
    for (int i = 0; i < 8; ++i) { const f32x4 d = v[i] - mu; q += d[0] * d[0] + d[1] * d[1] + d[2] * d[2] + d[3] * d[3]; }
    const float rstd = rsqrtf(wsum(q) * (1.0f / 2048.0f) + LN_EPS);
#pragma unroll
    for (int i = 0; i < 8; ++i) { const int c = 4 * (lane + 64 * i); v[i] = (v[i] - mu) * rstd * *(const f32x4*)(g + c) + *(const f32x4*)(bta + c); }
}
__device__ __forceinline__ void store_row(const f32x4 (&v)[8], int row, float* dstf, bf16_t* dstb) {
    const int lane = threadIdx.x & 63;
#pragma unroll
    for (int i = 0; i < 8; ++i) { const size_t o = (size_t)row * 2048 + 4 * (lane + 64 * i);
        if (dstf) *(f32x4*)(dstf + o) = v[i];
        if (dstb) { u32x2 w; w.x = cvt_pk_bf16(v[i][0], v[i][1]); w.y = cvt_pk_bf16(v[i][2], v[i][3]); *(u32x2*)(dstb + o) = w; } }
}
__device__ __forceinline__ void fp7_ln1(const FParams& f) {
    const int wid = threadIdx.x >> 6; const float* R1 = f.R1;
    for (int row = blockIdx.x * 8 + wid; row < NTOK; row += gridDim.x * 8) {
        f32x4 v[8];
        ln_row([=](int r, int c) __attribute__((always_inline)) { return *(const f32x4*)(R1 + (size_t)r * 2048 + c); }, row, f.np.ln1_g, f.np.ln1_b, v);
        store_row(v, row, f.R1, f.X1B);
    }
}
__device__ __forceinline__ void fp14_final(const FParams& f) {
    const int wid = threadIdx.x >> 6; const float* X2 = f.R2; const float* Y = f.YF;
    for (int row = blockIdx.x * 8 + wid; row < NTOK; row += gridDim.x * 8) {
        f32x4 v[8];
        ln_row([=](int r, int c) __attribute__((always_inline)) {
            return *(const f32x4*)(X2 + (size_t)r * 2048 + c) * DN_ALPHA + *(const f32x4*)(Y + (size_t)(2 * r) * 2048 + c) + *(const f32x4*)(Y + (size_t)(2 * r + 1) * 2048 + c); },
            row, f.np.ln3_g, f.np.ln3_b, v);
        store_row(v, row, f.np.out, nullptr);
    }
}
__device__ __forceinline__ void fp11_ln2_router(const FParams& f, float* lds) {
    const Params& p = f.np;
    const int tid = threadIdx.x, wid = tid >> 6, lane = tid & 63;
    float* xs = lds; float* part = lds + 8 * 2048; float* partg = part + 8 * 8 * 64;
    const float* R2 = f.R2;
    for (int row0 = blockIdx.x * 8; row0 < NTOK; row0 += gridDim.x * 8) {
        const int row = row0 + wid;
        {
            f32x4 v[8];
            ln_row([=](int r, int c) __attribute__((always_inline)) { return *(const f32x4*)(R2 + (size_t)r * 2048 + c); }, row, p.ln2_g, p.ln2_b, v);
            store_row(v, row, f.R2, f.X2B);
            __syncthreads();
#pragma unroll
            for (int i = 0; i < 8; ++i) *(f32x4*)(xs + wid * 2048 + 4 * (lane + 64 * i)) = v[i];
        }
        __syncthreads();
        {
            float acc[8], accg[8];
#pragma unroll
            for (int t = 0; t < 8; ++t) { acc[t] = 0.f; accg[t] = 0.f; }
            const int d0 = wid * 256;
            for (int dd = 0; dd < 256; ++dd) {
                const int d = d0 + dd;
                const float w = p.w_router_exp[(size_t)d * NEXP + lane];
#pragma unroll
                for (int t = 0; t < 8; ++t) acc[t] = fmaf(xs[t * 2048 + d], w, acc[t]);
            }
            for (int dd = (lane >> 2); dd < 256; dd += 16) {
                const int d = d0 + dd;
                const float w = p.w_router_grp[(size_t)d * 4 + (lane & 3)];
#pragma unroll
                for (int t = 0; t < 8; ++t) accg[t] = fmaf(xs[t * 2048 + d], w, accg[t]);
            }
#pragma unroll
            for (int t = 0; t < 8; ++t) { part[(wid * 8 + t) * 64 + lane] = acc[t]; partg[(wid * 8 + t) * 64 + lane] = accg[t]; }
        }
        __syncthreads();
        {
            float le = 0.f, lg = 0.f;
#pragma unroll
            for (int w = 0; w < 8; ++w) { le += part[(w * 8 + wid) * 64 + lane]; lg += partg[(w * 8 + wid) * 64 + lane]; }
            lg += __shfl_xor(lg, 4); lg += __shfl_xor(lg, 8); lg += __shfl_xor(lg, 16); lg += __shfl_xor(lg, 32);
            le += p.b_router_exp[lane];
            lg += p.b_router_grp[lane & 3];
            float g0 = __shfl(lg, 0), g1 = __shfl(lg, 1), g2 = __shfl(lg, 2), g3 = __shfl(lg, 3);
            float gm = fmaxf(fmaxf(g0, g1), fmaxf(g2, g3));
            float e0 = expf(g0 - gm), e1 = expf(g1 - gm), e2 = expf(g2 - gm), e3 = expf(g3 - gm);
            float gs = e0 + e1 + e2 + e3;
            float p0 = e0 / gs, p1 = e1 / gs, p2 = e2 / gs, p3 = e3 / gs;
            int grp = 0; float pg = p0;
            if (p1 > pg) { pg = p1; grp = 1; }
            if (p2 > pg) { pg = p2; grp = 2; }
            if (p3 > pg) { pg = p3; grp = 3; }
            float lv[16];
#pragma unroll
            for (int i = 0; i < 16; ++i) lv[i] = __shfl(le, grp * 16 + i);
            float mx = lv[0];
#pragma unroll
            for (int i = 1; i < 16; ++i) mx = fmaxf(mx, lv[i]);
            float sum = 0.f;
#pragma unroll
            for (int i = 0; i < 16; ++i) { lv[i] = expf(lv[i] - mx); sum += lv[i]; }
            int i1 = 0; float v1 = lv[0];
#pragma unroll
            for (int i = 1; i < 16; ++i) if (lv[i] > v1) { v1 = lv[i]; i1 = i; }
            int i2 = -1; float v2 = -1.f;
#pragma unroll
            for (int i = 0; i < 16; ++i) if (i != i1 && lv[i] > v2) { v2 = lv[i]; i2 = i; }
            float pa = v1 / sum, pb = v2 / sum;
            float den = pa + pb;
            float w1 = pg * pa / den, w2 = pg * pb / den;
            if (lane == 0) {
                int ea = grp * 16 + i1, eb = grp * 16 + i2;
                int sa = atomicAdd(&p.CNT[ea], 1);
                p.LIST[ea * LISTCAP + sa] = row * 2 + 0;
                int sb = atomicAdd(&p.CNT[eb], 1);
                p.LIST[eb * LISTCAP + sb] = row * 2 + 1;
                p.WGT[row * 2 + 0] = w1;
                p.WGT[row * 2 + 1] = w2;
            }
        }
    }
}
__device__ __forceinline__ void fp2_sgu(const FParams& f, char* lds) {
    using namespace att;
    const int tid = threadIdx.x, wid = __builtin_amdgcn_readfirstlane(tid >> 6), lane = tid & 63, r32 = lane & 31, hi = lane >> 5;
    f32x2* stat = (f32x2*)(lds + 4 * SHM_V);
    const bf16_t* U = f.UVG; const bf16_t* VG = f.UVG + (size_t)NTOK * 2048;
    const int sr = tid >> 4, sc = (tid & 15) * 8;
    const int rb = wid & 3, ch = wid >> 2;
    for (int unit = blockIdx.x; unit < (NTOK / 128) * 8; unit += gridDim.x) {
        const int cidx = unit >> 3, g = unit & 7, tok0 = cidx * 128;
        __syncthreads();
        if (tid < 128) {
            const f32x2* sp = (const f32x2*)(f.STATP + (size_t)(tok0 + tid) * 64);
            float s = 0.f, q = 0.f;
#pragma unroll 8
            for (int i = 0; i < 32; ++i) { const f32x2 v = sp[i]; s += v.x; q += v.y; }
            const float mu = s * (1.0f / 2048.0f);
            const float var = fmaxf(q * (1.0f / 2048.0f) - mu * mu, 0.f);
            f32x2 o; o.x = mu; o.y = rsqrtf(var + LN_EPS); stat[tid] = o;
        }
        __syncthreads();
#pragma unroll
        for (int kt = 0; kt < 2; ++kt)
#pragma unroll
            for (int c2 = 0; c2 < 2; ++c2) {
                const int col = g * 256 + c2 * 128 + sc;
                const f32x4 g0 = *(const f32x4*)(f.np.sgu_ln_g + col), g1 = *(const f32x4*)(f.np.sgu_ln_g + col + 4);
                const f32x4 b0 = *(const f32x4*)(f.np.sgu_ln_b + col), b1 = *(const f32x4*)(f.np.sgu_ln_b + col + 4);
#pragma unroll
                for (int hh = 0; hh < 2; ++hh) {
                    const int srow = kt * 64 + hh * 32 + sr;
                    const f32x2 st = stat[srow];
                    f32x4 x0, x1; unpack8bf(*(const u32x4*)(VG + (size_t)(tok0 + srow) * 2048 + col), x0, x1);
                    x0 = (x0 - st.x) * st.y * g0 + b0; x1 = (x1 - st.x) * st.y * g1 + b1;
                    *(u32x4*)(lds + (kt * 2 + c2) * SHM_V + v_st(hh * 32 + sr, sc)) = pack8bf(x0, x1);
                }
            }
        __syncthreads();
        f32x16 o[4] = {};
        const bf16_t* wrow = f.WSC + ((size_t)g * 128 + rb * 32 + r32) * 128 + hi * 8;
#pragma unroll
        for (int kt = 0; kt < 2; ++kt) {
            if (kt * 64 <= rb * 32 + 31) {
                const bf16x8 pa0 = load8(wrow + kt * 64), pa1 = load8(wrow + kt * 64 + 16), pa2 = load8(wrow + kt * 64 + 32), pa3 = load8(wrow + kt * 64 + 48);
                const int vb0 = (int)(uintptr_t)(lds + (kt * 2 + ch) * SHM_V) + v_rd_base(lane);
                pv_tile<0, false>(o, vb0, pa0, pa1, pa2, pa3, true);
            }
        }
#pragma unroll
        for (int r = 0; r < 16; ++r) {
            const int t = rb * 32 + crow(r, hi);
            const float bs = f.np.sgu_b_s[g * 128 + t];
#pragma unroll
            for (int d0 = 0; d0 < 4; ++d0) {
                const size_t off = (size_t)(tok0 + t) * 2048 + g * 256 + ch * 128 + d0 * 32 + r32;
                const float v = (o[d0][r] + bs) * bf2f(U[off]);
                const float vn = __shfl_xor(v, 1);
                if ((r32 & 1) == 0) *(unsigned*)(f.OSGUB + off) = cvtpk(v, vn);
            }
        }
    }
}
struct CmpOrder {
    int G, c;
    __device__ bool next(int i, Unit& u) const { const int L = i * G + c; if (L >= 64) return false; u.e = L >> 3; u.pn = L & 7; u.pm = 0; u.mvalid = 256; return true; }
};
struct CmpProb {
    const bf16_t* KVB; const bf16_t* W1T; int lda, ldb;
    __device__ __forceinline__ const char* a_base(const Unit& u) const { return (const char*)(KVB + (size_t)u.e * SEQ * 128 + u.pn * 512); }
    __device__ __forceinline__ const char* b_base(const Unit& u) const { return (const char*)(W1T + (size_t)(u.e >> 2) * 256 * 4096 + u.pn * 512); }
    __device__ __forceinline__ unsigned a_off(const Unit&, int h, int R, int C) const { return (unsigned)(((h * HALF + R) * 2048 + C) * 2); }
};
__device__ __forceinline__ void fp2_compress(const FParams& f, LAS unsigned char* lds) {
    float* PART = f.PART;
    CmpOrder S{(int)gridDim.x, (int)blockIdx.x};
    CmpProb P{f.KVB, f.W1_T, 2048, 4096};
    auto E = make_epi([=](const Unit& u, int rl, int c, f32x4 v0, f32x4 v1) __attribute__((always_inline)) {
        float* o = PART + (((size_t)(u.e * 8 + u.pn) * 256 + rl) * 256 + (c - u.pn * BM));
        *(f32x4*)o = v0; *(f32x4*)(o + 4) = v1;
    });
    gemm_phase(lds, P, 512, S, E);
}
__device__ __forceinline__ void fp2c_cmp_out(const FParams& f, float* lds) {
    const Params& p = f.np;
    const int tid = threadIdx.x, wid = tid >> 6, lane = tid & 63;
    float* hid = lds + wid * 256;
    for (int row = blockIdx.x * 8 + wid; row < 8 * 256; row += gridDim.x * 8) {
        const int e = row >> 8, i = row & 255, kv = e >> 2, g = (e >> 1) & 1, b = e & 1;
        bf16_t* dst = (kv ? f.VCB : f.KCB) + ((size_t)(b * 2 + g) * 256 + i) * 128;
        if (i == 255) { dst[lane] = 0; dst[lane + 64] = 0; continue; }
#pragma unroll
        for (int j = 0; j < 4; ++j) {
            const int n = lane + 64 * j;
            float s = f.BIAS1[kv * 256 + n];
#pragma unroll
            for (int ks = 0; ks < 8; ++ks) s += f.PART[((size_t)(e * 8 + ks) * 256 + i) * 256 + n];
            hid[n] = gelu_tanh(s);
        }
        __builtin_amdgcn_fence(__ATOMIC_RELEASE, "wavefront"); __builtin_amdgcn_wave_barrier(); __builtin_amdgcn_fence(__ATOMIC_ACQUIRE, "wavefront");
        const float* w2 = kv ? p.cmp_w2_v : p.cmp_w2_k;
        float o0 = 0.f, o1 = 0.f;
        for (int n = 0; n < 256; ++n) { const float h = hid[n]; o0 = fmaf(h, w2[n * 128 + lane], o0); o1 = fmaf(h, w2[n * 128 + 64 + lane], o1); }
        if (kv == 0) {
            const float c = f.ROPE[((size_t)(16 * i + 31) * 64 + lane) * 2], s = f.ROPE[((size_t)(16 * i + 31) * 64 + lane) * 2 + 1];
            const float t1 = o0, t2 = o1; o0 = t1 * c - t2 * s; o1 = t1 * s + t2 * c;
        }
        dst[lane] = (bf16_t)(cvt_pk_bf16(o0, 0.f) & 0xffffu); dst[lane + 64] = (bf16_t)(cvt_pk_bf16(o1, 0.f) & 0xffffu);
        __builtin_amdgcn_wave_barrier();
    }
}
__device__ __forceinline__ void fp3_cmp_attn(const FParams& f, char* lds) {
    const bf16_t* Q = f.Q; const bf16_t* KCB = f.KCB; const bf16_t* VCB = f.VCB; const bf16_t* MSEL = f.MSEL; float* OACC = f.OACC; float* IMPACC = f.IMPACC; const float* GATES = f.GATES;
    const int nb = gridDim.x;
    {
        using GEO = att::Geo<2048, 128, 256, 0, 0>;
        for (int it = blockIdx.x; it < 128; it += nb) {
            const int half = it & 1, qb = (it >> 1) & 15, g = (it >> 5) & 1, b = it >> 6;
            const int tok0 = b * SEQ + qb * 256;
            attn_stream<0, false, false, GEO, true>(4, [=](int i) __attribute__((always_inline)) {
                const int h = g * 8 + half * 4 + i;
                att::BlockRef r;
                r.Q = Q + (size_t)tok0 * 2048 + h * 128; r.P0 = qb * 256;
                r.K = KCB + (size_t)(b * 2 + g) * 256 * 128; r.V = MSEL;
                r.OACC = IMPACC + ((size_t)half * NTOK + tok0) * 256 + g * 128; r.OUTB = nullptr; r.gate = nullptr; r.rowmask = nullptr;
                return r; }, 256, 1 << 28, lds);
        }
    }
    {
        using GEO = att::Geo<2048, 128, 2048, 48, 0>;
        const int first = (int)((blockIdx.x + nb - 128) % nb);
        for (int it0 = first * 4; it0 < 512; it0 += nb * 4) {
            attn_stream<3, false, false, GEO, true>(4, [=](int i) __attribute__((always_inline)) {
                const int it = it0 + i;
                const int qb = it & 15, h = (it >> 4) & 15, b = it >> 8, g = h >> 3;
                const int tok0 = b * SEQ + qb * 256;
                att::BlockRef r;
                r.Q = Q + (size_t)tok0 * 2048 + h * 128; r.P0 = qb * 256;
                r.K = KCB + (size_t)(b * 2 + g) * 256 * 128; r.V = VCB + (size_t)(b * 2 + g) * 256 * 128;
                r.OACC = OACC + (size_t)tok0 * 2048 + h * 128; r.OUTB = nullptr; r.gate = GATES + (size_t)tok0 * 48 + h * 3; r.rowmask = nullptr;
                return r; }, 256, 1 << 28, lds);
        }
    }
}
__device__ __forceinline__ void fp3b_topk(const FParams& f) {
    const int tid = threadIdx.x, wid = tid >> 6, lane = tid & 63;
    for (int u = blockIdx.x * 8 + wid; u < NTOK * 2; u += gridDim.x * 8) {
        const int tok = u >> 1, g = u & 1, t = tok & (SEQ - 1), cur = t >> 6;
        const float imp = f.IMPACC[(size_t)tok * 256 + g * 128 + lane] + f.IMPACC[((size_t)NTOK + tok) * 256 + g * 128 + lane];
        const int j = lane;
        const bool forced = (j == 0) || (j == cur) || (j == cur - 1);
        const float me = forced ? 1e9f : (j <= cur ? imp : -1e9f);
        int rank = 0;
        for (int jj = 0; jj < 64; ++jj) { const float o = __shfl(me, jj); rank += (o > me || (o == me && jj < j)) ? 1 : 0; }
        const unsigned long long m = __ballot(rank < 16);
        if (lane == 0) f.np.SELMASK[u] = m;
    }
}
__global__ void __launch_bounds__(FTHR, 2) fast_kernel(FParams f) {
    extern __shared__ __attribute__((aligned(16))) unsigned char lds_raw[];
    LAS unsigned char* lds = (LAS unsigned char*)lds_raw;
    cg::grid_group grid = cg::this_grid();
    const int lo = f.np.phase_lo, hi = f.np.phase_hi;
    const Params& p = f.np;
#define PH(k, body) if (lo <= (k) && (k) < hi) { body; if ((k) + 1 < hi) grid.sync(); }
    PH(0, fp0_prologue(f, (float*)lds_raw))
    PH(1, fp1_xw(f, lds))
    PH(2, fp2_compress(f, lds); fp2_sgu(f, (char*)lds_raw); grid.sync(); fp2c_cmp_out(f, (float*)lds_raw))
    PH(3, fp3_cmp_attn(f, (char*)lds_raw); grid.sync(); fp3b_topk(f))
    PH(4, fp4_attn(f, (char*)lds_raw))
    PH(5, if (f.dbg & 6) { if (f.dbg & 4) cvt_rows(p.ONSA, f.ONSAB, (size_t)NTOK * 2048 / 8); if (f.dbg & 2) cvt_rows(p.OSGU, f.OSGUB, (size_t)NTOK * 2048 / 8); grid.sync(); } fp5_proj(f, lds))
    PH(6, fp6_wo(f, lds))
    PH(7, fp7_ln1(f))
    PH(8, if (f.dbg & 8) { cvt_rows(f.R1, f.X1B, (size_t)NTOK * 2048 / 8); cvt_rows_back(f.KXV, 1024, 0, p.KX, 512, 512); cvt_rows_back(f.KXV, 1024, 512, p.VX, 512, 512); grid.sync(); } fp8_xq(f, lds))
    PH(9, fp9_xattn(f, (char*)lds_raw))
    PH(10, if (f.dbg & 16) { cvt_rows(p.OX, f.OXB, (size_t)NTOK * 512 / 8); grid.sync(); } fp10_xo(f, lds))
    PH(11, fp11_ln2_router(f, (float*)lds_raw))
    PH(12, if (f.dbg & 32) { fp_conv_experts(f, (float*)lds_raw); grid.sync(); } fp12_moe_up(f, lds))
    PH(13, fp13_moe_down(f, lds))
    PH(14, fp14_final(f))
#undef PH
}
#ifndef HYBRID
#define HYBRID 1
#endif
constexpr int FAST_PHASES = 2;
constexpr int NAIVE_RESUME = 2;

extern "C" void kernel_launch(void* const* d_in, const int* in_sizes, int n_in, void* d_out, int out_size, void* d_ws, size_t ws_size,
                              hipStream_t stream) {
    static int grid_n = 0, grid_f = 0;
    if (!grid_n) {
        int dev = 0, cus = 0, per_cu = 0;
        (void)hipGetDevice(&dev);
        (void)hipDeviceGetAttribute(&cus, hipDeviceAttributeMultiprocessorCount, dev);
        (void)hipOccupancyMaxActiveBlocksPerMultiprocessor(&per_cu, naive_kernel, NTHR, 0);
        if (per_cu > 4) per_cu = 4;
        if (per_cu < 1) per_cu = 1;
        grid_n = cus * per_cu;
        (void)hipFuncSetAttribute((const void*)fast_kernel, hipFuncAttributeMaxDynamicSharedMemorySize, LDS_BYTES);
        int per_cu_f = 0;
        (void)hipOccupancyMaxActiveBlocksPerMultiprocessor(&per_cu_f, fast_kernel, FTHR, LDS_BYTES);
        grid_f = cus;
        fprintf(stderr, "kernel_launch: cus %d naive per_cu %d grid %d | fast per_cu %d grid %d | ws %zu\n", cus, per_cu, grid_n, per_cu_f, grid_f, ws_size);
    }
    FParams f{};
    Params& p = f.np;
    const float* const* in = (const float* const*)d_in;
    p.x = in[0]; p.mem = in[1]; p.w_in = in[2];
    p.cmp_pe_k = in[3]; p.cmp_w1_k = in[4]; p.cmp_w2_k = in[5];
    p.cmp_pe_v = in[6]; p.cmp_w1_v = in[7]; p.cmp_w2_v = in[8];
    p.sgu_ln_g = in[9]; p.sgu_ln_b = in[10]; p.sgu_w_s = in[11]; p.sgu_b_s = in[12];
    p.w_branch_a = in[13]; p.w_branch_b = in[14]; p.w_o = in[15]; p.ln1_g = in[16]; p.ln1_b = in[17];
    p.w_xq = in[18]; p.w_xk = in[19]; p.w_xv = in[20]; p.w_xo = in[21]; p.ln2_g = in[22]; p.ln2_b = in[23];
    p.w_router_grp = in[24]; p.b_router_grp = in[25]; p.w_router_exp = in[26]; p.b_router_exp = in[27];
    p.w_exp_gate = in[28]; p.w_exp_up = in[29]; p.w_exp_down = in[30]; p.ln3_g = in[31]; p.ln3_b = in[32];
    p.out = (float*)d_out;
    char* ws = (char*)d_ws; size_t off = 0;
    auto take = [&](size_t bytes) { char* r = ws + off; off += (bytes + 255) & ~(size_t)255; return r; };
    p.XW = (float*)take((size_t)NTOK * INW * 4);
    p.KC = (float*)take((size_t)BATCH * NCMP * 2 * 128 * 4);
    p.VC = (float*)take((size_t)BATCH * NCMP * 2 * 128 * 4);
    p.OC = (float*)take((size_t)NTOK * 2048 * 4);
    p.SELMASK = (unsigned long long*)take((size_t)NTOK * 2 * 8);
    p.ONSA = (float*)take((size_t)NTOK * 2048 * 4);
    p.VN = (float*)take((size_t)NTOK * 2048 * 4);
    p.OSGU = (float*)take((size_t)NTOK * 2048 * 4);
    p.MERGED = (float*)take((size_t)NTOK * 2048 * 4);
    p.X1 = p.VN;
    p.X2 = p.OC;
    p.QX = (float*)take((size_t)NTOK * MEMW * 4);
    p.KX = (float*)take((size_t)512 * MEMW * 4);
    p.VX = (float*)take((size_t)512 * MEMW * 4);
    p.OX = (float*)take((size_t)NTOK * MEMW * 4);
    p.CNT = (int*)take(64 * 4);
    p.LIST = (int*)take((size_t)NEXP * LISTCAP * 4);
    p.WGT = (float*)take((size_t)NTOK * 2 * 4);
    p.HB = p.XW;
    p.Y = p.XW + (size_t)NTOK * 2 * EFF;
    f.XB = (bf16_t*)take((size_t)NTOK * 2048 * 2);
    f.MEMB = (bf16_t*)take((size_t)512 * 2048 * 2);
    f.WIN_T = (bf16_t*)take((size_t)NPAD * 2048 * 2);
    f.WA_T = (bf16_t*)take((size_t)2048 * 2048 * 2);
    f.WB_T = (bf16_t*)take((size_t)2048 * 2048 * 2);
    f.WO_T = (bf16_t*)take((size_t)2048 * 2048 * 2);
    f.WXQ_T = (bf16_t*)take((size_t)512 * 2048 * 2);
    f.WXKV_T = (bf16_t*)take((size_t)1024 * 2048 * 2);
    f.WXO_T = (bf16_t*)take((size_t)2048 * 512 * 2);
    f.ROPE = (float*)take((size_t)SEQ * 64 * 2 * 4);
    f.KVB = (bf16_t*)take((size_t)12 * 2 * SEQ * 128 * 2 + 65536);
    f.GATES = (float*)take((size_t)NTOK * 48 * 4);
    f.KXV = (bf16_t*)take((size_t)512 * 1024 * 2);
#if HYBRID
    f.Q = (bf16_t*)p.ONSA; f.ONSAB = f.Q + (size_t)NTOK * 2048;
    f.UVG = (bf16_t*)p.OSGU;
    f.OACC = (float*)take((size_t)NTOK * 2048 * 4);
    f.OSGUB = (bf16_t*)take((size_t)NTOK * 2048 * 2);
    f.STATP = (float*)take((size_t)NTOK * 64 * 4);
    f.WSC = (bf16_t*)take((size_t)8 * 128 * 128 * 2);
    f.BIAS1 = (float*)take(512 * 4);
    f.PART = (float*)take((size_t)64 * 256 * 256 * 4);
    f.KCB = (bf16_t*)take((size_t)4 * 256 * 128 * 2); f.VCB = (bf16_t*)take((size_t)4 * 256 * 128 * 2);
    f.MSEL = (bf16_t*)take((size_t)256 * 128 * 2);
    f.IMPACC = (float*)take((size_t)2 * NTOK * 256 * 4);
    f.W1_T = (bf16_t*)take((size_t)2 * 256 * 4096 * 2);
    f.MERGEDB = f.XB;
    f.X1B = f.WIN_T; f.QXB = f.WIN_T + (size_t)NTOK * 2048;
    { char* xw = (char*)p.XW;
      f.WD_T = (bf16_t*)xw; f.YF = (float*)(xw + 134217728); f.X2B = (bf16_t*)(xw + 268435456); f.HBB = f.X2B + (size_t)NTOK * 2048; f.OXB = f.HBB + (size_t)NTOK * 2 * EFF; }
    f.WGU_T = (bf16_t*)p.ONSA;
    f.R1 = p.X1; f.R2 = p.X2;
    p.Y = f.YF;
    f.dbg = 32;
#else
    f.Q = (bf16_t*)take((size_t)NTOK * 2048 * 2);
    f.UVG = (bf16_t*)take((size_t)NTOK * 8192 * 2);
    f.dbg = 0;
#endif
    if (off > ws_size) { fprintf(stderr, "kernel_launch: workspace too small: need %zu have %zu\n", off, ws_size); return; }
    auto launchF = [&](int lo, int hi) {
        FParams ff = f; ff.np.phase_lo = lo; ff.np.phase_hi = hi;
        void* args[] = {&ff};
        hipError_t e = hipLaunchCooperativeKernel((void*)fast_kernel, dim3(grid_f), dim3(FTHR), args, LDS_BYTES, stream);
        if (e != hipSuccess) fprintf(stderr, "fast cooperative launch failed: %s (grid %d)\n", hipGetErrorString(e), grid_f);
    };
    auto launchN = [&](int lo, int hi) {
        Params pn = p; pn.phase_lo = lo; pn.phase_hi = hi;
        void* args[] = {&pn};
        hipError_t e = hipLaunchCooperativeKernel((void*)naive_kernel, dim3(grid_n), dim3(NTHR), args, 0, stream);
        if (e != hipSuccess) fprintf(stderr, "naive cooperative launch failed: %s (grid %d)\n", hipGetErrorString(e), grid_n);
    };
#if HYBRID
    launchF(0, 15);
#else
    launchF(0, 15);
#endif
}
```
